# Optimizing an MI355X kernel written in HIP

```python
import math
import jax, jax.numpy as jnp
from jax import lax
import numpy as np

D_MODEL = 2048
BATCH = 16
SEQ = 2048
DEPTH = 2

N_MIXERS = 2
N_ATTN_LAYERS = (DEPTH + 1) // 2
N_LRU_LAYERS = DEPTH // 2
CHUNK = 64
LEFT_CHUNKS = 8
BAND = (LEFT_CHUNKS + 1) * CHUNK
ATT_HEADS = 16
ATT_HEAD_DIM = 128
D_ATT = ATT_HEADS * ATT_HEAD_DIM
MAX_REL_DIST = 256
N_REL = 2 * MAX_REL_DIST + 1
D_RNN = D_MODEL
LRU_BLOCKS = 16
LRU_BLOCK_W = D_RNN // LRU_BLOCKS
CONV_W = 4
RG_C = 8.0
LN_EPS = 1e-5
NEG_INF = -1e30
DEEPNORM_ALPHA = (2.0 * DEPTH) ** 0.25
DEEPNORM_BETA = (8.0 * DEPTH) ** -0.25

kernel_name = "chunked_attn_rglru_deepnorm_hybrid"


def _layer_norm(x, gain, bias):
    xf = x.astype(jnp.float32)
    mu = jnp.mean(xf, axis=-1, keepdims=True)
    var = jnp.mean(jnp.square(xf - mu), axis=-1, keepdims=True)
    y = (xf - mu) * lax.rsqrt(var + LN_EPS)
    return (y * gain.astype(jnp.float32) + bias.astype(jnp.float32)).astype(x.dtype)


def _rel_index():
    i = np.arange(CHUNK)[:, None]
    j = np.arange(BAND)[None, :]
    dist = i - (j - LEFT_CHUNKS * CHUNK)
    return (np.clip(dist, -MAX_REL_DIST, MAX_REL_DIST) + MAX_REL_DIST).astype(np.int32)


def _chunk_attention_mixer(h, w_in, w_out, rel_table):
    B, S, _ = h.shape
    nc = S // CHUNK
    proj = h @ w_in
    q, k, v, g = jnp.split(proj, 4, axis=-1)
    q = q.reshape(B, S, ATT_HEADS, ATT_HEAD_DIM) * (ATT_HEAD_DIM ** -0.5)
    pad = ((0, 0), (LEFT_CHUNKS * CHUNK, 0), (0, 0), (0, 0))
    kp = jnp.pad(k.reshape(B, S, ATT_HEADS, ATT_HEAD_DIM), pad)
    vp = jnp.pad(v.reshape(B, S, ATT_HEADS, ATT_HEAD_DIM), pad)
    qc = q.reshape(B, nc, CHUNK, ATT_HEADS, ATT_HEAD_DIM).transpose(1, 0, 2, 3, 4)
    bias = rel_table.astype(jnp.float32)[:, jnp.asarray(_rel_index())]
    band_pos = jnp.arange(BAND) - LEFT_CHUNKS * CHUNK

    def one_chunk(args):
        c, q_blk = args
        kb = lax.dynamic_slice_in_dim(kp, c * CHUNK, BAND, axis=1)
        vb = lax.dynamic_slice_in_dim(vp, c * CHUNK, BAND, axis=1)
        s = jnp.einsum('bqhd,bkhd->bhqk', q_blk, kb).astype(jnp.float32) + bias
        valid = (band_pos + c * CHUNK) >= 0
        s = jnp.where(valid[None, None, None, :], s, NEG_INF)
        p = jax.nn.softmax(s, axis=-1).astype(vb.dtype)
        return jnp.einsum('bhqk,bkhd->bqhd', p, vb)

    o = lax.map(one_chunk, (jnp.arange(nc), qc))
    o = o.transpose(1, 0, 2, 3, 4).reshape(B, S, D_ATT)
    return (o * jax.nn.silu(g)) @ w_out


def _lru_combine(left, right):
    a1, b1 = left
    a2, b2 = right
    return a1 * a2, a2 * b1 + b2


def _rglru_mixer(h, w_in, conv_w, conv_b, w_a, b_a, w_x, b_x, lam, w_out):
    B, S, _ = h.shape
    proj = h @ w_in
    u, g = jnp.split(proj, 2, axis=-1)
    up = jnp.pad(u, ((0, 0), (CONV_W - 1, 0), (0, 0)))
    u = conv_b + sum(up[:, t:t + S] * conv_w[t] for t in range(CONV_W))
    ub = u.reshape(B, S, LRU_BLOCKS, LRU_BLOCK_W)
    r = jax.nn.sigmoid(jnp.einsum('bsni,nij->bsnj', ub, w_a) + b_a).reshape(B, S, D_RNN)
    i = jax.nn.sigmoid(jnp.einsum('bsni,nij->bsnj', ub, w_x) + b_x).reshape(B, S, D_RNN)
    log_a = -RG_C * r.astype(jnp.float32) * jax.nn.softplus(-lam.astype(jnp.float32))
    a = jnp.exp(log_a)
    mult = jnp.sqrt(-jnp.expm1(2.0 * log_a))
    b = mult * (i * u).astype(jnp.float32)
    _, hs = lax.associative_scan(_lru_combine, (a, b), axis=1)
    y = hs.astype(h.dtype) * jax.nn.silu(g)
    return y @ w_out


def setup_inputs(seed: int = 0) -> dict:
    key = jax.random.key(seed)
    ks = jax.random.split(key, 16)
    f32 = jnp.float32
    x = jax.random.normal(ks[0], (BATCH, SEQ, D_MODEL), f32)

    attn_w_in = jax.random.normal(ks[1], (N_ATTN_LAYERS, D_MODEL, 4 * D_ATT), f32) * D_MODEL ** -0.5
    col_scale = jnp.concatenate([jnp.ones((2 * D_ATT,), f32),
                                 jnp.full((D_ATT,), DEEPNORM_BETA, f32),
                                 jnp.ones((D_ATT,), f32)])
    attn_w_in = attn_w_in * col_scale
    attn_w_out = jax.random.normal(ks[2], (N_ATTN_LAYERS, D_ATT, D_MODEL), f32) * (D_ATT ** -0.5) * DEEPNORM_BETA
    attn_rel_bias = jax.random.normal(ks[3], (N_ATTN_LAYERS, ATT_HEADS, N_REL), f32) * 0.1

    lru_w_in = jax.random.normal(ks[4], (N_LRU_LAYERS, D_MODEL, 2 * D_RNN), f32) * D_MODEL ** -0.5
    lru_conv_w = jax.random.normal(ks[5], (N_LRU_LAYERS, CONV_W, D_RNN), f32) * CONV_W ** -0.5
    lru_conv_b = jax.random.normal(ks[6], (N_LRU_LAYERS, D_RNN), f32) * 0.02
    lru_wa = jax.random.normal(ks[7], (N_LRU_LAYERS, LRU_BLOCKS, LRU_BLOCK_W, LRU_BLOCK_W), f32) * LRU_BLOCK_W ** -0.5
    lru_ba = jax.random.normal(ks[8], (N_LRU_LAYERS, LRU_BLOCKS, LRU_BLOCK_W), f32) * 0.02
    lru_wx = jax.random.normal(ks[9], (N_LRU_LAYERS, LRU_BLOCKS, LRU_BLOCK_W, LRU_BLOCK_W), f32) * LRU_BLOCK_W ** -0.5
    lru_bx = jax.random.normal(ks[10], (N_LRU_LAYERS, LRU_BLOCKS, LRU_BLOCK_W), f32) * 0.02
    a_c = jax.random.uniform(ks[11], (N_LRU_LAYERS, D_RNN), f32, 0.9, 0.999)
    s = a_c ** (1.0 / RG_C)
    lru_lambda = jnp.log(s) - jnp.log1p(-s)
    lru_w_out = jax.random.normal(ks[12], (N_LRU_LAYERS, D_RNN, D_MODEL), f32) * (D_RNN ** -0.5) * DEEPNORM_BETA

    ln_gain = 1.0 + 0.02 * jax.random.normal(ks[13], (DEPTH, D_MODEL), f32)
    ln_bias = 0.02 * jax.random.normal(ks[14], (DEPTH, D_MODEL), f32)
    return {"x": x, "attn_w_in": attn_w_in, "attn_w_out": attn_w_out, "attn_rel_bias": attn_rel_bias,
            "lru_w_in": lru_w_in, "lru_conv_w": lru_conv_w, "lru_conv_b": lru_conv_b,
            "lru_wa": lru_wa, "lru_ba": lru_ba, "lru_wx": lru_wx, "lru_bx": lru_bx,
            "lru_lambda": lru_lambda, "lru_w_out": lru_w_out,
            "ln_gain": ln_gain, "ln_bias": ln_bias}


def reference(x, attn_w_in, attn_w_out, attn_rel_bias, lru_w_in, lru_conv_w, lru_conv_b,
              lru_wa, lru_ba, lru_wx, lru_bx, lru_lambda, lru_w_out, ln_gain, ln_bias):
    h = x
    for layer in range(DEPTH):
        j = layer // N_MIXERS
        if layer % N_MIXERS == 0:
            y = _chunk_attention_mixer(h, attn_w_in[j], attn_w_out[j], attn_rel_bias[j])
        else:
            y = _rglru_mixer(h, lru_w_in[j], lru_conv_w[j], lru_conv_b[j], lru_wa[j], lru_ba[j],
                             lru_wx[j], lru_bx[j], lru_lambda[j], lru_w_out[j])
        h = _layer_norm(DEEPNORM_ALPHA * h + y, ln_gain[layer], ln_bias[layer])
    return h
```

```cpp
#include <hip/hip_runtime.h>
#include <cstdio>
#include <cstdint>
namespace pg8 {
#define PG8_LAS __attribute__((address_space(3)))
typedef unsigned short bf16_t;
typedef short bf16x8 __attribute__((ext_vector_type(8)));
typedef float f32x4 __attribute__((ext_vector_type(4)));
typedef unsigned u32x4 __attribute__((ext_vector_type(4)));
constexpr int BM = 256, BK = 64, HALF = 128, HTB = HALF * BK * 2  , STAGE_BYTES = 8 * HTB, NXCD = 8, WGM = 8;

__host__ __device__ __forceinline__ int lds_byte(int r, int c) { const int st = (r >> 4) * 2 + (c >> 5), rr = r & 15, cc = c & 31, ob = rr * 64 + cc * 2; return st * 1024 + (ob ^ (((ob >> 9) & 1) << 5)); }
__host__ __device__ __forceinline__ void stage_rc(int b, int& R, int& C) { const int st = b / 1024, sb = b % 1024, swz = sb ^ (((sb >> 9) & 1) << 5); R = (st >> 1) * 16 + swz / 64; C = (st & 1) * 32 + (swz % 64) / 2; }
__host__ __device__ __forceinline__ int perm32(int rho) { const int n = rho >> 4, i = rho & 15; return 8 * (i >> 2) + 4 * n + (i & 3); }

struct Unit { int pm, pn; };
struct Gemm { const bf16_t* A; const bf16_t* Bt; int M, N, K; };

struct StaticOrder {
    int nM, nN, nwg, G, c;
    __host__ __device__ void init(int M, int N, int G_, int c_) { nM = M / BM; nN = N / BM; nwg = nM * nN; G = G_; c = c_; }
    __host__ __device__ bool next(int i, Unit& u) const {
        const long L = (long)i * G + c; if (L >= nwg) return false;
        int wgid = (int)L; { const int q = nwg / NXCD, r = nwg % NXCD, xcd = wgid % NXCD, off = wgid / NXCD; wgid = (xcd < r ? xcd * (q + 1) : r * (q + 1) + (xcd - r) * q) + off; }
        const int nig = WGM * nN, gid = wgid / nig, fm = gid * WGM, gsz = (nM - fm) < WGM ? (nM - fm) : WGM;
        u.pm = fm + ((wgid % nig) % gsz); u.pn = (wgid % nig) / gsz; return true;
    }
    __device__ __forceinline__ void a_ready(const Unit&) const {}
    __device__ __forceinline__ void done(const Unit&) const {}
};

__device__ __forceinline__ unsigned cvt_pk_bf16(float lo, float hi) { unsigned r; asm volatile("v_cvt_pk_bf16_f32 %0, %1, %2" : "=v"(r) : "v"(lo), "v"(hi)); return r; }
template <int ACT  > struct EpiBf16 {
    static constexpr bool PERM = true, AFTER_DRAIN = false; static_assert(ACT == 0, "EpiBf16: ACT is 0 (none)");
    bf16_t* O; int ldc; const float* bias; int split_cols; size_t split_stride; float scale0;
    __device__ __forceinline__ void operator()(const f32x4 (&acc)[2][2][4][2], const Unit& u, int wr, int wc, int fr, int fq) const {
        const int row0 = u.pm * BM + wr * 64 + fr; int colt = u.pn * BM; bf16_t* base = O;
        float sc = 1.f; if (split_cols) { const int t = colt / split_cols; base += (size_t)t * split_stride; colt -= t * split_cols; if (t == 0) sc = scale0; }
        const int col0 = colt + wc * 32 + 8 * fq, bcol0 = u.pn * BM + wc * 32 + 8 * fq;
        f32x4 bv[2][2];
#pragma unroll
        for (int bj = 0; bj < 2; ++bj)
#pragma unroll
            for (int n = 0; n < 2; ++n) bv[bj][n] = bias ? *(const f32x4*)(bias + bcol0 + bj * HALF + 4 * n) : (f32x4){0.f, 0.f, 0.f, 0.f};
#pragma unroll
        for (int ai = 0; ai < 2; ++ai)
#pragma unroll
            for (int m = 0; m < 4; ++m) { bf16_t* rowp = base + (size_t)(row0 + ai * HALF + m * 16) * ldc + col0;
#pragma unroll
                for (int bj = 0; bj < 2; ++bj) { f32x4 v0 = acc[ai][bj][m][0] + bv[bj][0], v1 = acc[ai][bj][m][1] + bv[bj][1];
                    v0 = v0 * sc; v1 = v1 * sc; u32x4 w; w.x = cvt_pk_bf16(v0[0], v0[1]); w.y = cvt_pk_bf16(v0[2], v0[3]); w.z = cvt_pk_bf16(v1[0], v1[1]); w.w = cvt_pk_bf16(v1[2], v1[3]);
                    *(u32x4*)(rowp + bj * HALF) = w; } }
    }
};
typedef float f32x2e __attribute__((ext_vector_type(2)));
__device__ __forceinline__ float hsum4(const f32x4 v) { return (v[0] + v[1]) + (v[2] + v[3]); }
__device__ __forceinline__ float hsq4(const f32x4 v) { return (v[0] * v[0] + v[1] * v[1]) + (v[2] * v[2] + v[3] * v[3]); }

struct EpiRes0 {
    static constexpr bool PERM = true, AFTER_DRAIN = false;
    const float* xres; float* Z; bf16_t* Zb; f32x2e* part; int ldc; int Mrows; float alpha;
    __device__ __forceinline__ void operator()(const f32x4 (&acc)[2][2][4][2], const Unit& u, int wr, int wc, int fr, int fq) const {
        const int row0 = u.pm * BM + wr * 64 + fr, col0 = u.pn * BM + wc * 32 + 8 * fq;
        f32x2e* pp = part + (size_t)(u.pn * 4 + wc) * Mrows;
#pragma unroll
        for (int ai = 0; ai < 2; ++ai)
#pragma unroll
            for (int m = 0; m < 4; ++m) { const int row = row0 + ai * HALF + m * 16; const size_t off = (size_t)row * ldc + col0; float s = 0.f, q = 0.f;
#pragma unroll
                for (int bj = 0; bj < 2; ++bj) {
                    const f32x4 xa = *(const f32x4*)(xres + off + bj * HALF), xb = *(const f32x4*)(xres + off + bj * HALF + 4);
                    const f32x4 v0 = xa * alpha + acc[ai][bj][m][0], v1 = xb * alpha + acc[ai][bj][m][1];
                    *(f32x4*)(Z + off + bj * HALF) = v0; *(f32x4*)(Z + off + bj * HALF + 4) = v1;
                    u32x4 w; w.x = cvt_pk_bf16(v0[0], v0[1]); w.y = cvt_pk_bf16(v0[2], v0[3]); w.z = cvt_pk_bf16(v1[0], v1[1]); w.w = cvt_pk_bf16(v1[2], v1[3]);
                    *(u32x4*)(Zb + off + bj * HALF) = w;
                    s += hsum4(v0) + hsum4(v1); q += hsq4(v0) + hsq4(v1); }
                s += __shfl_xor(s, 16); s += __shfl_xor(s, 32); q += __shfl_xor(q, 16); q += __shfl_xor(q, 32);
                if (fq == 0) pp[row] = (f32x2e){s, q};
                if (m & 1) asm volatile("" ::: "memory"); }
    }
};
struct EpiRes1 {
    static constexpr bool PERM = true, AFTER_DRAIN = false;
    const float* z0; const f32x2e* st0; const float* gain; const float* bias; float* Z; f32x2e* part; int ldc; int Mrows; float alpha;
    __device__ __forceinline__ void operator()(const f32x4 (&acc)[2][2][4][2], const Unit& u, int wr, int wc, int fr, int fq) const {
        const int row0 = u.pm * BM + wr * 64 + fr, col0 = u.pn * BM + wc * 32 + 8 * fq;
        f32x2e* pp = part + (size_t)(u.pn * 4 + wc) * Mrows;
        f32x4 gv[2][2], bv[2][2];
#pragma unroll
        for (int bj = 0; bj < 2; ++bj)
#pragma unroll
            for (int n = 0; n < 2; ++n) { gv[bj][n] = *(const f32x4*)(gain + col0 + bj * HALF + 4 * n); bv[bj][n] = *(const f32x4*)(bias + col0 + bj * HALF + 4 * n); }
#pragma unroll
        for (int ai = 0; ai < 2; ++ai)
#pragma unroll
            for (int m = 0; m < 4; ++m) { const int row = row0 + ai * HALF + m * 16; const size_t off = (size_t)row * ldc + col0; float s = 0.f, q = 0.f;
                const f32x2e st = st0[row]; const float mu = st.x, rs = st.y;
#pragma unroll
                for (int bj = 0; bj < 2; ++bj) {
                    const f32x4 xa = *(const f32x4*)(z0 + off + bj * HALF), xb = *(const f32x4*)(z0 + off + bj * HALF + 4);
                    const f32x4 h0 = ((xa - mu) * rs) * gv[bj][0] + bv[bj][0], h1 = ((xb - mu) * rs) * gv[bj][1] + bv[bj][1];
                    const f32x4 v0 = h0 * alpha + acc[ai][bj][m][0], v1 = h1 * alpha + acc[ai][bj][m][1];
                    *(f32x4*)(Z + off + bj * HALF) = v0; *(f32x4*)(Z + off + bj * HALF + 4) = v1;
                    s += hsum4(v0) + hsum4(v1); q += hsq4(v0) + hsq4(v1); }
                s += __shfl_xor(s, 16); s += __shfl_xor(s, 32); q += __shfl_xor(q, 16); q += __shfl_xor(q, 32);
                if (fq == 0) pp[row] = (f32x2e){s, q};
                if (m & 1) asm volatile("" ::: "memory"); }
    }
};
struct EpiLnFold {
    static constexpr bool PERM = true, AFTER_DRAIN = false;
    bf16_t* O; int ldc; const f32x2e* st0; const float* csum; const float* cb; int split_cols; size_t split_stride;
    __device__ __forceinline__ void operator()(const f32x4 (&acc)[2][2][4][2], const Unit& u, int wr, int wc, int fr, int fq) const {
        const int row0 = u.pm * BM + wr * 64 + fr; int colt = u.pn * BM; bf16_t* base = O;
        { const int t = colt / split_cols; base += (size_t)t * split_stride; colt -= t * split_cols; }
        const int col0 = colt + wc * 32 + 8 * fq, bcol0 = u.pn * BM + wc * 32 + 8 * fq;
        f32x4 cs[2][2], cbv[2][2];
#pragma unroll
        for (int bj = 0; bj < 2; ++bj)
#pragma unroll
            for (int n = 0; n < 2; ++n) { cs[bj][n] = *(const f32x4*)(csum + bcol0 + bj * HALF + 4 * n); cbv[bj][n] = *(const f32x4*)(cb + bcol0 + bj * HALF + 4 * n); }
#pragma unroll
        for (int ai = 0; ai < 2; ++ai)
#pragma unroll
            for (int m = 0; m < 4; ++m) { const int row = row0 + ai * HALF + m * 16; bf16_t* rowp = base + (size_t)row * ldc + col0;
                const f32x2e st = st0[row]; const float mu = st.x, rs = st.y;
#pragma unroll
                for (int bj = 0; bj < 2; ++bj) {
                    const f32x4 v0 = (acc[ai][bj][m][0] - cs[bj][0] * mu) * rs + cbv[bj][0], v1 = (acc[ai][bj][m][1] - cs[bj][1] * mu) * rs + cbv[bj][1];
                    u32x4 w; w.x = cvt_pk_bf16(v0[0], v0[1]); w.y = cvt_pk_bf16(v0[2], v0[3]); w.z = cvt_pk_bf16(v1[0], v1[1]); w.w = cvt_pk_bf16(v1[2], v1[3]);
                    *(u32x4*)(rowp + bj * HALF) = w; } }
    }
};
template <class Epi, class Sched, bool ALIGN_EPI = false, bool SP2 = false>
__device__ __forceinline__ void gemm_phase(PG8_LAS unsigned char* lds, const Gemm g, const Sched& S, const Epi& E) {
    const int tid = threadIdx.x, wid = __builtin_amdgcn_readfirstlane(tid >> 6), lane = tid & 63, wr = wid >> 2, wc = wid & 3, fr = lane & 15, fq = lane >> 4;
    const int K = g.K, nt = K / BK;
    unsigned voffA[2], voffB[2];
#pragma unroll
    for (int i = 0; i < 2; ++i) { int R, C; stage_rc(tid * 16 + i * 8192, R, C); const int Rb = Epi::PERM ? ((R & ~31) + perm32(R & 31)) : R;
        voffA[i] = (unsigned)(R * K + C) * 2u; voffB[i] = (unsigned)(Rb * K + C) * 2u; }
    const size_t kstep = (size_t)(BK * 2);
    const size_t hstep = (size_t)HALF * K * 2;
    const size_t tstep = 2 * hstep;
    const unsigned ldsw = (unsigned)wid * 1024u;
    const int aoff = lds_byte(wr * 64 + fr, fq * 8), boff = lds_byte(wc * 32 + fr, fq * 8);
#define PG8_SA(b, h) (((b) * 2 + (h)) * HTB)
#define PG8_SB(b, h) ((4 + (b) * 2 + (h)) * HTB)
#define PG8_STAGE(bufoff, gbase, voff) do { _Pragma("unroll") for (int _i = 0; _i < 2; ++_i) \
        __builtin_amdgcn_global_load_lds((const unsigned*)((const char*)(gbase) + (voff)[_i]), (PG8_LAS unsigned*)(lds + (bufoff) + ldsw + _i * 8192), 16, 0, 0); } while (0)
#define PG8_LDA(dst, b, h) do { _Pragma("unroll") for (int m = 0; m < 4; ++m) _Pragma("unroll") for (int k = 0; k < 2; ++k) dst[m][k] = *(const PG8_LAS bf16x8*)(lds + PG8_SA(b, h) + aoff + m * 2048 + k * 1024); } while (0)
#define PG8_LDB(dst, b, h) do { _Pragma("unroll") for (int n = 0; n < 2; ++n) _Pragma("unroll") for (int k = 0; k < 2; ++k) dst[n][k] = *(const PG8_LAS bf16x8*)(lds + PG8_SB(b, h) + boff + n * 2048 + k * 1024); } while (0)
#define PG8_MMA(ai, bj, At, Bt) do { __builtin_amdgcn_s_setprio(1); _Pragma("unroll") for (int m = 0; m < 4; ++m) _Pragma("unroll") for (int n = 0; n < 2; ++n) _Pragma("unroll") for (int k = 0; k < 2; ++k) \
        acc[ai][bj][m][n] = __builtin_amdgcn_mfma_f32_16x16x32_bf16(Bt[n][k], At[m][k], acc[ai][bj][m][n], 0, 0, 0); __builtin_amdgcn_s_setprio(0); } while (0)
#define PG8_WAIT_V(n) asm volatile("s_waitcnt vmcnt(" #n ")" ::: "memory")
#define PG8_WAIT_L(n) asm volatile("s_waitcnt lgkmcnt(" #n ")" ::: "memory")
#define PG8_BAR __builtin_amdgcn_s_barrier()
#define PG8_SCHED __builtin_amdgcn_sched_barrier(0)
    Unit cur, nxt; int ui = 0;
    if (!S.next(0, cur)) return;
    f32x4 acc[2][2][4][2];
#pragma unroll
    for (int a = 0; a < 2; ++a)
#pragma unroll
        for (int b = 0; b < 2; ++b)
#pragma unroll
            for (int m = 0; m < 4; ++m)
#pragma unroll
                for (int n = 0; n < 2; ++n) acc[a][b][m][n] = (f32x4){0.f, 0.f, 0.f, 0.f};
    bf16x8 At[4][2], B0[2][2], B1[2][2];
    const char* cA = (const char*)g.A + (size_t)cur.pm * tstep; const char* cB = (const char*)g.Bt + (size_t)cur.pn * tstep;
    S.a_ready(cur);
    if constexpr (SP2) {
        PG8_STAGE(PG8_SB(0, 0), cB, voffB); PG8_STAGE(PG8_SB(0, 1), cB + hstep, voffB); PG8_STAGE(PG8_SA(0, 0), cA, voffA); PG8_STAGE(PG8_SA(0, 1), cA + hstep, voffA);
        if (wr == 1) PG8_BAR;
        PG8_WAIT_V(2); PG8_BAR;
        PG8_STAGE(PG8_SB(1, 0), cB + kstep, voffB); PG8_STAGE(PG8_SA(1, 0), cA + kstep, voffA); PG8_STAGE(PG8_SB(1, 1), cB + hstep + kstep, voffB);
        PG8_WAIT_V(6); PG8_BAR;
    } else {
        PG8_STAGE(PG8_SB(0, 0), cB, voffB); PG8_STAGE(PG8_SA(0, 0), cA, voffA); PG8_STAGE(PG8_SB(0, 1), cB + hstep, voffB); PG8_STAGE(PG8_SA(0, 1), cA + hstep, voffA);
        if (wr == 1) PG8_BAR;
        PG8_WAIT_V(4); PG8_BAR;
        PG8_STAGE(PG8_SB(1, 0), cB + kstep, voffB); PG8_STAGE(PG8_SA(1, 0), cA + kstep, voffA); PG8_STAGE(PG8_SB(1, 1), cB + hstep + kstep, voffB);
        PG8_WAIT_V(6); PG8_BAR;
    }
    for (;;) {
        const bool has_next = S.next(ui + 1, nxt);
        const char* nA = has_next ? (const char*)g.A + (size_t)nxt.pm * tstep : cA; const char* nB = has_next ? (const char*)g.Bt + (size_t)nxt.pn * tstep : cB;
        for (int t = 0; t < nt; t += 2) {
            const bool last = (t == nt - 2);
            const char* a1 = cA + (size_t)(t + 1) * kstep;
            const char* a2 = last ? nA : cA + (size_t)(t + 2) * kstep; const char* b2 = last ? nB : cB + (size_t)(t + 2) * kstep;
            const char* a3 = a2 + kstep; const char* b3 = b2 + kstep;
            if (last && has_next) S.a_ready(nxt);
            if constexpr (SP2) {
            PG8_LDB(B0, 0, 0); PG8_LDB(B1, 0, 1); PG8_SCHED; PG8_LDA(At, 0, 0); PG8_STAGE(PG8_SA(1, 1), a1 + hstep, voffA);
            PG8_WAIT_V(8); PG8_WAIT_L(0); PG8_BAR; PG8_MMA(0, 0, At, B0); PG8_MMA(0, 1, At, B1); PG8_BAR; PG8_SCHED;
            PG8_LDA(At, 0, 1); PG8_STAGE(PG8_SB(0, 0), b2, voffB); PG8_STAGE(PG8_SB(0, 1), b2 + hstep, voffB); PG8_STAGE(PG8_SA(0, 0), a2, voffA);
            PG8_WAIT_V(8); PG8_WAIT_L(0); PG8_BAR; PG8_MMA(1, 0, At, B0); PG8_MMA(1, 1, At, B1); PG8_BAR; PG8_SCHED;
            PG8_LDB(B0, 1, 0); PG8_LDB(B1, 1, 1); PG8_SCHED; PG8_LDA(At, 1, 0); PG8_STAGE(PG8_SA(0, 1), a2 + hstep, voffA);
            PG8_WAIT_V(8); PG8_WAIT_L(0); PG8_BAR; PG8_MMA(0, 0, At, B0); PG8_MMA(0, 1, At, B1); PG8_BAR; PG8_SCHED;
            PG8_LDA(At, 1, 1); PG8_STAGE(PG8_SB(1, 0), b3, voffB); PG8_STAGE(PG8_SB(1, 1), b3 + hstep, voffB); PG8_STAGE(PG8_SA(1, 0), a3, voffA);
            PG8_WAIT_V(8); PG8_WAIT_L(0); PG8_BAR; PG8_MMA(1, 0, At, B0); PG8_MMA(1, 1, At, B1); PG8_BAR; PG8_SCHED;
            } else {
            PG8_LDB(B0, 0, 0); PG8_SCHED; PG8_LDA(At, 0, 0); PG8_STAGE(PG8_SA(1, 1), a1 + hstep, voffA);
            PG8_WAIT_L(8); PG8_BAR; PG8_WAIT_L(0); PG8_MMA(0, 0, At, B0); PG8_BAR; PG8_SCHED;
            PG8_LDB(B1, 0, 1); PG8_STAGE(PG8_SB(0, 0), b2, voffB);
            PG8_BAR; PG8_WAIT_L(0); PG8_MMA(0, 1, At, B1); PG8_BAR;
            PG8_LDA(At, 0, 1); PG8_STAGE(PG8_SA(0, 0), a2, voffA);
            PG8_BAR; PG8_WAIT_L(0); PG8_MMA(1, 0, At, B0); PG8_BAR; PG8_SCHED;
            PG8_STAGE(PG8_SB(0, 1), b2 + hstep, voffB);
            PG8_WAIT_V(6); PG8_BAR; PG8_MMA(1, 1, At, B1); PG8_BAR;
            PG8_LDB(B0, 1, 0); PG8_SCHED; PG8_LDA(At, 1, 0); PG8_STAGE(PG8_SA(0, 1), a2 + hstep, voffA);
            PG8_WAIT_L(8); PG8_BAR; PG8_WAIT_L(0); PG8_MMA(0, 0, At, B0); PG8_BAR; PG8_SCHED;
            PG8_LDB(B1, 1, 1); PG8_STAGE(PG8_SB(1, 0), b3, voffB);
            PG8_BAR; PG8_WAIT_L(0); PG8_MMA(0, 1, At, B1); PG8_BAR;
            PG8_LDA(At, 1, 1); PG8_STAGE(PG8_SA(1, 0), a3, voffA);
            PG8_BAR; PG8_WAIT_L(0); PG8_MMA(1, 0, At, B0); PG8_BAR; PG8_SCHED;
            PG8_STAGE(PG8_SB(1, 1), b3 + hstep, voffB);
            PG8_WAIT_V(6); PG8_BAR; PG8_MMA(1, 1, At, B1); PG8_BAR;
            }
        }
        if constexpr (ALIGN_EPI) { if (wr == 0) PG8_BAR; }
        if constexpr (!Epi::AFTER_DRAIN) { E(acc, cur, wr, wc, fr, fq); S.done(cur); }
        if (!has_next) break;
#pragma unroll
        for (int a = 0; a < 2; ++a)
#pragma unroll
            for (int b = 0; b < 2; ++b)
#pragma unroll
                for (int m = 0; m < 4; ++m)
#pragma unroll
                    for (int n = 0; n < 2; ++n) acc[a][b][m][n] = (f32x4){0.f, 0.f, 0.f, 0.f};
        cur = nxt; cA = nA; cB = nB; ++ui;
        if constexpr (ALIGN_EPI) { if (wr == 1) PG8_BAR; }
    }
    PG8_WAIT_V(0);
    if constexpr (!ALIGN_EPI) { if (wr == 0) PG8_BAR; }
    PG8_BAR;
    if constexpr (Epi::AFTER_DRAIN) { E.fused(acc, cur, wr, wc, fr, fq, lds, wid, lane); S.done(cur); }
#undef PG8_SA
#undef PG8_SB
#undef PG8_STAGE
#undef PG8_LDA
#undef PG8_LDB
#undef PG8_MMA
#undef PG8_WAIT_V
#undef PG8_WAIT_L
#undef PG8_BAR
#undef PG8_SCHED
}
}

namespace att {
typedef short bf16x8 __attribute__((ext_vector_type(8)));
typedef short s16x4 __attribute__((ext_vector_type(4)));
typedef float f32x16 __attribute__((ext_vector_type(16)));
typedef float f32x4a __attribute__((ext_vector_type(4)));
typedef unsigned u32x4 __attribute__((ext_vector_type(4)));
typedef unsigned u32x2 __attribute__((ext_vector_type(2)));
#define ATT_LAS __attribute__((address_space(3)))
constexpr int SEQ = 2048, PITCH = 2048, NQG = 8;
constexpr int KVB = 16384;
constexpr int LDS_V = 0, LDS_K = 2 * KVB;
constexpr int STG_STRIDE = 272, STG_WAVE = 32 * STG_STRIDE;
constexpr int TL_N = 640;
constexpr float THR = 6.0f;
__device__ __forceinline__ unsigned cvtpk(float lo, float hi) { unsigned r; asm volatile("v_cvt_pk_bf16_f32 %0, %1, %2" : "=v"(r) : "v"(lo), "v"(hi)); return r; }
__device__ __forceinline__ int kswz(int row, int colB) { return row * 256 + (colB ^ ((row & 7) << 4)); }
__device__ __forceinline__ int v_st(int k, int c) { return ((k >> 3) * 4 + (c >> 5)) * 512 + ((k & 7) * 32 + (c & 31)) * 2; }
__device__ __forceinline__ int v_rd_base(int lane) { return ((lane & 3) << 3) | (((lane >> 2) & 3) << 6) | (((lane >> 4) & 1) << 5) | (((lane >> 5) & 1) << 8); }
typedef short v4i16_t __attribute__((ext_vector_type(4)));
__device__ __forceinline__ s16x4 vtr(const ATT_LAS char* p) { return __builtin_bit_cast(s16x4, __builtin_amdgcn_ds_read_tr16_b64_v4i16((ATT_LAS v4i16_t*)p)); }
#define ATT_PK(L, H) (bf16x8){L[0], L[1], L[2], L[3], H[0], H[1], H[2], H[3]}
template <int D0> __device__ __forceinline__ void pv_one(f32x16& od, const ATT_LAS char* vb, bf16x8 pb0, bf16x8 pb1, bf16x8 pb2, bf16x8 pb3) {
    const s16x4 l0 = vtr(vb + D0 * 512 + 0 * 4096), h0 = vtr(vb + D0 * 512 + 0 * 4096 + 2048), l1 = vtr(vb + D0 * 512 + 1 * 4096), h1 = vtr(vb + D0 * 512 + 1 * 4096 + 2048);
    const s16x4 l2 = vtr(vb + D0 * 512 + 2 * 4096), h2 = vtr(vb + D0 * 512 + 2 * 4096 + 2048), l3 = vtr(vb + D0 * 512 + 3 * 4096), h3 = vtr(vb + D0 * 512 + 3 * 4096 + 2048);
    od = __builtin_amdgcn_mfma_f32_32x32x16_bf16(ATT_PK(l0, h0), pb0, od, 0, 0, 0);
    od = __builtin_amdgcn_mfma_f32_32x32x16_bf16(ATT_PK(l1, h1), pb1, od, 0, 0, 0);
    od = __builtin_amdgcn_mfma_f32_32x32x16_bf16(ATT_PK(l2, h2), pb2, od, 0, 0, 0);
    od = __builtin_amdgcn_mfma_f32_32x32x16_bf16(ATT_PK(l3, h3), pb3, od, 0, 0, 0);
}
struct Tensors { const unsigned short* Q; const unsigned short* K; const unsigned short* V; const unsigned short* G; unsigned short* O; const float* table; };

__device__ __forceinline__ void attn_bh(ATT_LAS unsigned char* lds, ATT_LAS float* tl, const Tensors& T, int b, int h) {
    const int tid = threadIdx.x, lane = tid & 63, r32 = lane & 31, hi = lane >> 5; const int wid = __builtin_amdgcn_readfirstlane(tid >> 6);
    for (int e = tid; e < TL_N; e += 512) { int d = 575 - e; d = d > 256 ? 256 : d; d = d < -256 ? -256 : d; tl[e] = T.table[h * 513 + d + 256] * 1.4426950408889634f; }
    const int ci = wid < 4 ? wid : 7 - wid, hf = wid >> 2;
    const size_t rowb = (size_t)b * SEQ;
    const unsigned short* Kh = T.K + rowb * PITCH + h * 128; const unsigned short* Vh = T.V + rowb * PITCH + h * 128;
    const int sr = tid >> 4, sc = (tid & 15) * 8;
    const int vst0 = v_st(sr, sc), vst1 = v_st(32 + sr, sc), kst0 = kswz(sr, sc * 2), kst1 = kswz(32 + sr, sc * 2);
    const ATT_LAS char* vrd = (const ATT_LAS char*)lds + LDS_V + v_rd_base(lane);
    __syncthreads();
    for (int qg = 0; qg < NQG; ++qg) {
        const int c0 = 4 * qg, t_lo = c0 - 8 > 0 ? c0 - 8 : 0, t_hi = c0 + 3;
        const int c = c0 + ci, my_lo = c - 8 > 0 ? c - 8 : 0, my_hi = c;
        const int qw0 = c * 64 + hf * 32;
        bf16x8 qr[8];
        { const unsigned short* Qw = T.Q + (rowb + qw0 + r32) * PITCH + h * 128 + hi * 8;
#pragma unroll
          for (int d0 = 0; d0 < 8; ++d0) qr[d0] = *(const bf16x8*)(Qw + d0 * 16); }
        float m_reg = -1e30f, l_reg = 0.f; f32x16 o[4];
#pragma unroll
        for (int d = 0; d < 4; ++d)
#pragma unroll
            for (int r = 0; r < 16; ++r) o[d][r] = 0.f;
        bf16x8 sv0, sv1, sk0, sk1;
#define ATT_SLOAD(t) do { const size_t k0_ = (size_t)(t) * 64; sv0 = *(const bf16x8*)(Vh + (k0_ + sr) * PITCH + sc); sv1 = *(const bf16x8*)(Vh + (k0_ + 32 + sr) * PITCH + sc); \
        sk0 = *(const bf16x8*)(Kh + (k0_ + sr) * PITCH + sc); sk1 = *(const bf16x8*)(Kh + (k0_ + 32 + sr) * PITCH + sc); } while (0)
#define ATT_SWRITE(bf) do { *(ATT_LAS bf16x8*)(lds + LDS_V + (bf) * KVB + vst0) = sv0; *(ATT_LAS bf16x8*)(lds + LDS_V + (bf) * KVB + vst1) = sv1; \
        *(ATT_LAS bf16x8*)(lds + LDS_K + (bf) * KVB + kst0) = sk0; *(ATT_LAS bf16x8*)(lds + LDS_K + (bf) * KVB + kst1) = sk1; } while (0)
        ATT_SLOAD(t_lo); ATT_SWRITE(0); __syncthreads();
        for (int t = t_lo; t <= t_hi; ++t) {
            const int cur = (t - t_lo) & 1;
            if (t < t_hi) ATT_SLOAD(t + 1);
            if (t >= my_lo && t <= my_hi) {
                const ATT_LAS float* tb = tl + (575 - (qw0 - t * 64) - r32 + 4 * hi);
                f32x16 p0, p1;
#pragma unroll
                for (int r = 0; r < 16; ++r) { p0[r] = tb[(r & 3) + 8 * (r >> 2)]; p1[r] = tb[32 + (r & 3) + 8 * (r >> 2)]; }
                const ATT_LAS char* Ks = (const ATT_LAS char*)lds + LDS_K + cur * KVB;
#pragma unroll
                for (int d0 = 0; d0 < 8; ++d0) { const int cb = (d0 * 16 + hi * 8) * 2;
                    const bf16x8 b0 = *(const ATT_LAS bf16x8*)(Ks + kswz(r32, cb)), b1 = *(const ATT_LAS bf16x8*)(Ks + kswz(32 + r32, cb));
                    p0 = __builtin_amdgcn_mfma_f32_32x32x16_bf16(b0, qr[d0], p0, 0, 0, 0);
                    p1 = __builtin_amdgcn_mfma_f32_32x32x16_bf16(b1, qr[d0], p1, 0, 0, 0); }
                float pmax = p0[0];
#pragma unroll
                for (int r = 1; r < 16; ++r) pmax = fmaxf(pmax, p0[r]);
#pragma unroll
                for (int r = 0; r < 16; ++r) pmax = fmaxf(pmax, p1[r]);
                { auto rr = __builtin_amdgcn_permlane32_swap(__float_as_uint(pmax), __float_as_uint(pmax), false, false); pmax = fmaxf(__uint_as_float(rr[0]), __uint_as_float(rr[1])); }
                if (!__all(pmax - m_reg <= THR)) {
                    const float mn = fmaxf(m_reg, pmax), alpha = __builtin_amdgcn_exp2f(m_reg - mn); m_reg = mn; l_reg *= alpha;
#pragma unroll
                    for (int d = 0; d < 4; ++d)
#pragma unroll
                        for (int r = 0; r < 16; ++r) o[d][r] *= alpha;
                }
                float ps = 0.f;
#pragma unroll
                for (int r = 0; r < 16; ++r) { p0[r] = __builtin_amdgcn_exp2f(p0[r] - m_reg); ps += p0[r]; }
#pragma unroll
                for (int r = 0; r < 16; ++r) { p1[r] = __builtin_amdgcn_exp2f(p1[r] - m_reg); ps += p1[r]; }
                l_reg += ps;
                u32x4 w0 = {cvtpk(p0[0], p0[1]), cvtpk(p0[2], p0[3]), cvtpk(p0[4], p0[5]), cvtpk(p0[6], p0[7])};
                u32x4 w1 = {cvtpk(p0[8], p0[9]), cvtpk(p0[10], p0[11]), cvtpk(p0[12], p0[13]), cvtpk(p0[14], p0[15])};
                u32x4 w2 = {cvtpk(p1[0], p1[1]), cvtpk(p1[2], p1[3]), cvtpk(p1[4], p1[5]), cvtpk(p1[6], p1[7])};
                u32x4 w3 = {cvtpk(p1[8], p1[9]), cvtpk(p1[10], p1[11]), cvtpk(p1[12], p1[13]), cvtpk(p1[14], p1[15])};
                const bf16x8 pb0 = __builtin_bit_cast(bf16x8, w0), pb1 = __builtin_bit_cast(bf16x8, w1), pb2 = __builtin_bit_cast(bf16x8, w2), pb3 = __builtin_bit_cast(bf16x8, w3);
                const ATT_LAS char* vb = vrd + cur * KVB;
                pv_one<0>(o[0], vb, pb0, pb1, pb2, pb3); pv_one<1>(o[1], vb, pb0, pb1, pb2, pb3); pv_one<2>(o[2], vb, pb0, pb1, pb2, pb3); pv_one<3>(o[3], vb, pb0, pb1, pb2, pb3);
            }
            if (t < t_hi) ATT_SWRITE(cur ^ 1);
            __syncthreads();
        }
#undef ATT_SLOAD
#undef ATT_SWRITE
        { auto rr = __builtin_amdgcn_permlane32_swap(__float_as_uint(l_reg), __float_as_uint(l_reg), false, false); l_reg = __uint_as_float(rr[0]) + __uint_as_float(rr[1]); }
        const float linv = 1.0f / l_reg;
        ATT_LAS unsigned char* stg = lds + wid * STG_WAVE;
#pragma unroll
        for (int d0 = 0; d0 < 4; ++d0)
#pragma unroll
            for (int rq = 0; rq < 4; ++rq) { u32x2 w; w.x = cvtpk(o[d0][4 * rq] * linv, o[d0][4 * rq + 1] * linv); w.y = cvtpk(o[d0][4 * rq + 2] * linv, o[d0][4 * rq + 3] * linv);
                *(ATT_LAS u32x2*)(stg + r32 * STG_STRIDE + (32 * d0 + 8 * rq + 4 * hi) * 2) = w; }
        __builtin_amdgcn_fence(__ATOMIC_RELEASE, "wavefront"); asm volatile("s_waitcnt lgkmcnt(0)" ::: "memory");
        const size_t orow0 = rowb + qw0;
#pragma unroll
        for (int i = 0; i < 8; ++i) { const int row = 4 * i + (lane >> 4), ch = lane & 15;
            const u32x4 ov = *(const ATT_LAS u32x4*)(stg + row * STG_STRIDE + ch * 16);
            const size_t gi = (orow0 + row) * PITCH + h * 128 + ch * 8;
            const u32x4 gv = *(const u32x4*)(T.G + gi);
            u32x4 res;
#pragma unroll
            for (int j = 0; j < 4; ++j) {
                const float o_lo = __uint_as_float(ov[j] << 16), o_hi = __uint_as_float(ov[j] & 0xffff0000u);
                const float g_lo = __uint_as_float(gv[j] << 16), g_hi = __uint_as_float(gv[j] & 0xffff0000u);
                const float s_lo = g_lo * __builtin_amdgcn_rcpf(1.0f + __builtin_amdgcn_exp2f(-1.4426950408889634f * g_lo));
                const float s_hi = g_hi * __builtin_amdgcn_rcpf(1.0f + __builtin_amdgcn_exp2f(-1.4426950408889634f * g_hi));
                res[j] = cvtpk(o_lo * s_lo, o_hi * s_hi); }
            *(u32x4*)(T.O + gi) = res; }
        __syncthreads();
    }
}
#undef ATT_PK
}

namespace lru {
typedef short bf16x8 __attribute__((ext_vector_type(8)));
typedef float f32x4l __attribute__((ext_vector_type(4)));
typedef unsigned u32x4 __attribute__((ext_vector_type(4)));
typedef unsigned u32x2 __attribute__((ext_vector_type(2)));
#define LRU_LAS __attribute__((address_space(3)))
constexpr int SEQ = 2048, PITCH = 2048, NT = 32;
constexpr int L_RAW = 0, L_A = 17408, L_G = 33792  , L_SC = 66560  ;
constexpr float LOG2E = 1.4426950408889634f, LN2 = 0.6931471805599453f;
__device__ __forceinline__ unsigned cvtpk(float lo, float hi) { unsigned r; asm volatile("v_cvt_pk_bf16_f32 %0, %1, %2" : "=v"(r) : "v"(lo), "v"(hi)); return r; }
__device__ __forceinline__ float bf_lo(unsigned w) { return __uint_as_float(w << 16); }
__device__ __forceinline__ float bf_hi(unsigned w) { return __uint_as_float(w & 0xffff0000u); }
__device__ __forceinline__ float sigmoidf_fast(float x) { return __builtin_amdgcn_rcpf(1.0f + __builtin_amdgcn_exp2f(-LOG2E * x)); }
struct Params { const unsigned short* U; const unsigned short* G; unsigned short* Y;
    const float* conv_w; const float* conv_b; const float* wa; const float* ba; const float* wx; const float* bx; const float* lam; };

__device__ __forceinline__ void lru_bn(LRU_LAS unsigned char* lds, const Params& P, int b, int n) {
    const int tid = threadIdx.x, lane = tid & 63, nn = lane & 15, kq = lane >> 4; const int wid = __builtin_amdgcn_readfirstlane(tid >> 6);
    const size_t rowb = (size_t)b * SEQ;
    const unsigned short* Ub = P.U + rowb * PITCH + n * 128; const unsigned short* Gb = P.G + rowb * PITCH + n * 128; unsigned short* Yb = P.Y + rowb * PITCH + n * 128;
    bf16x8 Ba[4], Bx[4];
    { const float* wa0 = P.wa + (size_t)n * 128 * 128 + 16 * wid + nn; const float* wx0 = P.wx + (size_t)n * 128 * 128 + 16 * wid + nn;
#pragma unroll
      for (int ks = 0; ks < 4; ++ks) { u32x4 ta, tx;
#pragma unroll
          for (int j2 = 0; j2 < 4; ++j2) { const int i0 = 32 * ks + 8 * kq + 2 * j2;
              ta[j2] = cvtpk(wa0[(size_t)i0 * 128], wa0[(size_t)(i0 + 1) * 128]); tx[j2] = cvtpk(wx0[(size_t)i0 * 128], wx0[(size_t)(i0 + 1) * 128]); }
          Ba[ks] = __builtin_bit_cast(bf16x8, ta); Bx[ks] = __builtin_bit_cast(bf16x8, tx); } }
    const int chl = 16 * wid + nn, chg = n * 128 + chl;
    const float c_ba = P.ba[chg], c_bx = P.bx[chg];
    const float c_sp = -8.0f * log1pf(expf(-P.lam[chg])) * LOG2E;
    const int tt4 = tid >> 5, cg = tid & 31;
    f32x4l cw0, cw1, cw2, cw3, cbv;
    { const float* cwp = P.conv_w + n * 128 + 4 * cg; cw0 = *(const f32x4l*)(cwp); cw1 = *(const f32x4l*)(cwp + 2048); cw2 = *(const f32x4l*)(cwp + 4096); cw3 = *(const f32x4l*)(cwp + 6144);
      cbv = *(const f32x4l*)(P.conv_b + n * 128 + 4 * cg); }
    LRU_LAS unsigned char* raw = lds + L_RAW; LRU_LAS unsigned char* abuf = lds + L_A; LRU_LAS float* sc = (LRU_LAS float*)(lds + L_SC + wid * 2048);
    u32x4 ur0, ur1, ur2, gr0, gr1;
#define LRU_LOAD(t) do { const int t0_ = (t) * 64; \
        { const int p = tid, rw = p >> 4, gr = t0_ - 3 + rw; ur0 = gr >= 0 ? *(const u32x4*)(Ub + (size_t)gr * PITCH + (p & 15) * 8) : (u32x4){0u, 0u, 0u, 0u}; } \
        { const int p = tid + 512, rw = p >> 4, gr = t0_ - 3 + rw; ur1 = *(const u32x4*)(Ub + (size_t)gr * PITCH + (p & 15) * 8); } \
        { const int p = tid + 1024, rw = p >> 4, gr = t0_ - 3 + rw; ur2 = rw < 67 ? *(const u32x4*)(Ub + (size_t)gr * PITCH + (p & 15) * 8) : (u32x4){0u, 0u, 0u, 0u}; } \
        gr0 = *(const u32x4*)(Gb + (size_t)(t0_ + (tid >> 4)) * PITCH + (tid & 15) * 8); gr1 = *(const u32x4*)(Gb + (size_t)(t0_ + 32 + (tid >> 4)) * PITCH + (tid & 15) * 8); } while (0)
    float hc = 0.f;
    LRU_LOAD(0);
    for (int t = 0; t < NT; ++t) {
        LRU_LAS unsigned char* gbuf = lds + L_G + (t & 1) * 16384;
        *(LRU_LAS u32x4*)(raw + tid * 16) = ur0; *(LRU_LAS u32x4*)(raw + (tid + 512) * 16) = ur1; if (tid + 1024 < 67 * 16) *(LRU_LAS u32x4*)(raw + (tid + 1024) * 16) = ur2;
        *(LRU_LAS u32x4*)(gbuf + tid * 16) = gr0; *(LRU_LAS u32x4*)(gbuf + (tid + 512) * 16) = gr1;
        __syncthreads();
        if (t + 1 < NT) LRU_LOAD(t + 1);
        { u32x2 rr[7];
#pragma unroll
          for (int i = 0; i < 7; ++i) rr[i] = *(const LRU_LAS u32x2*)(raw + (4 * tt4 + i) * 256 + cg * 8);
#pragma unroll
          for (int i = 0; i < 4; ++i) { const int tk = 4 * tt4 + i;
              float v0 = cbv[0], v1 = cbv[1], v2 = cbv[2], v3 = cbv[3];
#define LRU_TAP(K, CW) do { const u32x2 x = rr[i + K]; v0 += CW[0] * bf_lo(x.x); v1 += CW[1] * bf_hi(x.x); v2 += CW[2] * bf_lo(x.y); v3 += CW[3] * bf_hi(x.y); } while (0)
              LRU_TAP(0, cw0); LRU_TAP(1, cw1); LRU_TAP(2, cw2); LRU_TAP(3, cw3);
#undef LRU_TAP
              u32x2 w; w.x = cvtpk(v0, v1); w.y = cvtpk(v2, v3);
              *(LRU_LAS u32x2*)(abuf + tk * 256 + (((cg >> 1) ^ (tk & 15)) << 4) + 8 * (cg & 1)) = w; } }
        __syncthreads();
        f32x4l ra[4], rx[4];
#pragma unroll
        for (int blk = 0; blk < 4; ++blk) { const int row = 16 * blk + nn; ra[blk] = (f32x4l){0.f, 0.f, 0.f, 0.f}; rx[blk] = (f32x4l){0.f, 0.f, 0.f, 0.f};
#pragma unroll
            for (int ks = 0; ks < 4; ++ks) { const bf16x8 af = *(const LRU_LAS bf16x8*)(abuf + row * 256 + (((4 * ks + kq) ^ (row & 15)) << 4));
                ra[blk] = __builtin_amdgcn_mfma_f32_16x16x32_bf16(af, Ba[ks], ra[blk], 0, 0, 0);
                rx[blk] = __builtin_amdgcn_mfma_f32_16x16x32_bf16(af, Bx[ks], rx[blk], 0, 0, 0); } }
        float av[4][4], bv[4][4]; f32x4l sA, sB;
#pragma unroll
        for (int blk = 0; blk < 4; ++blk) { float A4 = 1.f, B4 = 0.f;
#pragma unroll
            for (int rg = 0; rg < 4; ++rg) { const int tok = 16 * blk + 4 * kq + rg;
                const unsigned short ub = *(const LRU_LAS unsigned short*)(abuf + tok * 256 + (((chl >> 3) ^ (tok & 15)) << 4) + (chl & 7) * 2);
                const float up = __uint_as_float((unsigned)ub << 16);
                const float r = sigmoidf_fast(ra[blk][rg] + c_ba), ig = sigmoidf_fast(rx[blk][rg] + c_bx);
                const float l2a = c_sp * r, a = __builtin_amdgcn_exp2f(l2a);
                const float x2 = 2.0f * LN2 * l2a;
                const float em = x2 > -0.125f ? -x2 * (1.0f + x2 * (0.5f + x2 * (0.16666667f + x2 * 0.041666668f))) : 1.0f - a * a;
                const float bb = __builtin_amdgcn_sqrtf(em) * ig * up;
                av[blk][rg] = a; bv[blk][rg] = bb; A4 *= a; B4 = B4 * a + bb; }
            sA[blk] = A4; sB[blk] = B4; }
        *(LRU_LAS f32x4l*)(sc + (nn * 4 + kq) * 4) = sA; *(LRU_LAS f32x4l*)(sc + 256 + (nn * 4 + kq) * 4) = sB;
        __builtin_amdgcn_fence(__ATOMIC_RELEASE, "wavefront"); asm volatile("s_waitcnt lgkmcnt(0)" ::: "memory");
        f32x4l gA[4], gB[4];
#pragma unroll
        for (int q = 0; q < 4; ++q) { gA[q] = *(const LRU_LAS f32x4l*)(sc + nn * 16 + q * 4); gB[q] = *(const LRU_LAS f32x4l*)(sc + 256 + nn * 16 + q * 4); }
        float hin[4]; float h = hc;
#pragma unroll
        for (int s = 0; s < 16; ++s) { const int blk = s >> 2, q = s & 3; if (q == kq) hin[blk] = h; h = gA[q][blk] * h + gB[q][blk]; }
        hc = h;
        asm volatile("" ::: "memory");
#pragma unroll
        for (int blk = 0; blk < 4; ++blk) { float hh = hin[blk];
#pragma unroll
            for (int rg = 0; rg < 4; ++rg) { const int tok = 16 * blk + 4 * kq + rg;
                hh = av[blk][rg] * hh + bv[blk][rg];
                LRU_LAS unsigned short* gp = (LRU_LAS unsigned short*)(gbuf + tok * 256 + chl * 2);
                const float g = __uint_as_float((unsigned)(*gp) << 16);
                const float y = hh * g * sigmoidf_fast(g);
                *gp = (unsigned short)(cvtpk(y, 0.f) & 0xffffu); } }
        __syncthreads();
        { const u32x4 y0 = *(const LRU_LAS u32x4*)(gbuf + tid * 16), y1 = *(const LRU_LAS u32x4*)(gbuf + (tid + 512) * 16);
          *(u32x4*)(Yb + (size_t)(t * 64 + (tid >> 4)) * PITCH + (tid & 15) * 8) = y0; *(u32x4*)(Yb + (size_t)(t * 64 + 32 + (tid >> 4)) * PITCH + (tid & 15) * 8) = y1; }
    }
#undef LRU_LOAD
    __syncthreads();
}
}

#define GAS __attribute__((address_space(1)))
#define LAS __attribute__((address_space(3)))
typedef unsigned short bf16;
typedef unsigned v4u __attribute__((ext_vector_type(4)));
typedef float f32x4 __attribute__((ext_vector_type(4)));
typedef short bf16x8 __attribute__((ext_vector_type(8)));
typedef GAS unsigned gu32;
typedef GAS unsigned long long gu64;
#define RLX_AGENT __ATOMIC_RELAXED, __HIP_MEMORY_SCOPE_AGENT
#define LDS_WAIT() asm volatile("s_waitcnt lgkmcnt(0)" ::: "memory")
#define VM_WAIT() asm volatile("s_waitcnt vmcnt(0)" ::: "memory")
__device__ __forceinline__ unsigned long long rt() { return __builtin_amdgcn_s_memrealtime(); }
__device__ __forceinline__ unsigned f2bf(float f) { unsigned u = __builtin_bit_cast(unsigned, f); return (u + 0x7fffu + ((u >> 16) & 1u)) >> 16; }
__device__ __forceinline__ unsigned pk2(float lo, float hi) { return f2bf(lo) | (f2bf(hi) << 16); }

#define XB_TMO      128
#define XB_XCNT(j)  (256  + 64 * (j))
#define XB_XSUB(j)  (1280 + 64 * (j))
#define XB_XGEN(j)  (2304 + 64 * (j))
#define XB_TOP      3328
#define XB_TOPGEN   3392
#define XCD_BAR_WORDS 3456
#define XB_SPIN_CAP (1u << 18)

__device__ __forceinline__ unsigned xb_ld(unsigned* p)              { return __hip_atomic_load(p, __ATOMIC_RELAXED, __HIP_MEMORY_SCOPE_AGENT); }
__device__ __forceinline__ unsigned xb_add(unsigned* p, unsigned v) { return __hip_atomic_fetch_add(p, v, __ATOMIC_RELAXED, __HIP_MEMORY_SCOPE_AGENT); }
__device__ __forceinline__ unsigned xb_xcc_id() { return (unsigned)__builtin_amdgcn_s_getreg((3 << 11) | 20) & 0xFu; }
#define XB_SPIN(cond, bar) do { unsigned _sp = 0; while (cond) { __builtin_amdgcn_s_sleep(1); \
    if ((++_sp & 255u) == 0u) { if (xb_ld(&(bar)[XB_TMO])) break; if (_sp > XB_SPIN_CAP) { atomicAdd(&(bar)[XB_TMO], 1u); break; } } } } while (0)

struct XcdBarrier {
    unsigned* bar; unsigned x;
    volatile LAS unsigned* st;
};

__device__ __forceinline__ XcdBarrier xcd_barrier_post(unsigned* bar, volatile LAS unsigned* st) {
    XcdBarrier b; b.bar = bar; b.x = xb_xcc_id(); b.st = st;
    if (threadIdx.x == 0) (void)xb_add(&bar[XB_XCNT(b.x)], 1u);
    return b;
}
__device__ __forceinline__ void xcd_barrier_complete(unsigned* bar, unsigned x, unsigned& nloc, unsigned& nx) {
    const unsigned G = gridDim.x * gridDim.y * gridDim.z;
    unsigned sum, cnt, mine, sp = 0u;
    for (;;) {
        sum = 0u; cnt = 0u; mine = 0u;
#pragma unroll
        for (unsigned j = 0; j < 16; ++j) { const unsigned c = xb_ld(&bar[XB_XCNT(j)]); sum += c; cnt += (c > 0u) ? 1u : 0u; mine = (j == x) ? c : mine; }
        if (sum == G) break;
        __builtin_amdgcn_s_sleep(1);
        if ((++sp & 255u) == 0u) { if (xb_ld(&bar[XB_TMO])) break; if (sp > XB_SPIN_CAP) { atomicAdd(&bar[XB_TMO], 1u); break; } }
    }
    nloc = mine > 0u ? mine : 1u; nx = cnt > 0u ? cnt : 1u;
}

__device__ __forceinline__ void xcd_barrier(const XcdBarrier& b) {
    asm volatile("s_waitcnt vmcnt(0)" ::: "memory");
    __syncthreads();
    if (threadIdx.x == 0) {
        unsigned* bar = b.bar;
        __builtin_amdgcn_s_waitcnt(0);
        unsigned nloc = b.st[0], nx = b.st[1];
        if (nloc == 0u) { xcd_barrier_complete(bar, b.x, nloc, nx); b.st[0] = nloc; b.st[1] = nx; }
        const unsigned old = xb_add(&bar[XB_XSUB(b.x)], 1u);
        const unsigned gen = old / nloc;
        if (old + 1u == (gen + 1u) * nloc) {
            __builtin_amdgcn_fence(__ATOMIC_RELEASE, "agent");
            asm volatile("s_waitcnt vmcnt(0)" ::: "memory");
            const unsigned og = xb_add(&bar[XB_TOP], 1u);
            const unsigned tg = og / nx;
            if (og + 1u == (tg + 1u) * nx) xb_add(&bar[XB_TOPGEN], 1u);
            else XB_SPIN(xb_ld(&bar[XB_TOPGEN]) == tg, bar);
            __builtin_amdgcn_fence(__ATOMIC_ACQUIRE, "agent");
            xb_add(&bar[XB_XGEN(b.x)], 1u);
            asm volatile("s_waitcnt vmcnt(0)" ::: "memory");
        } else {
            XB_SPIN(xb_ld(&bar[XB_XGEN(b.x)]) == gen, bar);
            __builtin_amdgcn_fence(__ATOMIC_ACQUIRE, "agent");
            asm volatile("s_waitcnt vmcnt(0)" ::: "memory");
        }
    }
    __syncthreads();
}

constexpr int NWAVES = 8;
constexpr int BATCH = 16, SEQ = 2048, DM = 2048, NH = 16, HD = 128;
constexpr int M = BATCH * SEQ;
constexpr int N1 = 4 * DM, N3 = 2 * DM;
constexpr float LN_EPS = 1e-5f;
constexpr float DN_ALPHA = 1.4142135623730951f;
constexpr float QSCALE = 0.08838834764831845f * 1.4426950408889634f;

constexpr size_t MiB = 1u << 20;
constexpr size_t WS_CTL = 0, CTL_ZERO_BYTES = 1 * MiB;
constexpr size_t WS_W1T = 2 * MiB, WS_W2T = 34 * MiB, WS_W3T = 42 * MiB, WS_W4T = 58 * MiB;
constexpr size_t WS_CSP = 66 * MiB, WS_CBP = WS_CSP + 512 * 1024;
constexpr size_t WS_CSUM = 67 * MiB, WS_CB = WS_CSUM + 64 * 1024;
constexpr size_t WS_ST0 = 68 * MiB;
constexpr size_t WS_PART = 70 * MiB;
constexpr size_t WS_R0 = 80 * MiB, WS_R1 = 208 * MiB, WS_R2 = 336 * MiB, WS_R3 = 464 * MiB, WS_R4 = 592 * MiB, WS_END = 720 * MiB;
constexpr int CW_TMO = 0, CW_CODE = 1, CW_BAR = 4096;
static_assert((CW_BAR + 3456) * 4 <= (int)CTL_ZERO_BYTES, "barrier words inside the memset region");

constexpr int RING_OFF = 0, RING_BYTES = 131072;
constexpr int LDSCTL_OFF = RING_BYTES, MISC_OFF = LDSCTL_OFF + 320, TL_OFF = LDSCTL_OFF + 1024;
constexpr int LDS_BYTES = 147456;
static_assert(TL_OFF + 640 * 4 <= LDS_BYTES, "LDS map");

struct Frame {
    LAS unsigned char* lds; volatile LAS unsigned* MISC; gu32* ctl;
    int tid, lane, wave, vcu, G;
};
__device__ __forceinline__ unsigned cvt_pk(float lo, float hi) { unsigned r; asm volatile("v_cvt_pk_bf16_f32 %0, %1, %2" : "=v"(r) : "v"(lo), "v"(hi)); return r; }
__device__ __forceinline__ float wave_sum(float v) {
#pragma unroll
    for (int o = 1; o < 64; o <<= 1) v += __shfl_xor(v, o);
    return v;
}
template <bool FOLD>
__device__ __forceinline__ void p0_transpose_item(const float* W, int K, int N, bf16* WT, LAS float* scr, int item, int lane, const float* gain, const float* lbias, float* csp, float* cbp) {
    const int nblk = N / 32, kb = item / nblk, nb = item % nblk, k0 = 64 * kb, n0 = 32 * nb;
#pragma unroll 8
    for (int i = 0; i < 32; ++i) { const int kk = 2 * i + (lane >> 5); scr[kk * 33 + (lane & 31)] = W[(size_t)(k0 + kk) * N + n0 + (lane & 31)]; }
    LDS_WAIT(); asm volatile("" ::: "memory");
    const int c = lane & 7;
    float gk[8], bk[8];
#pragma unroll
    for (int i = 0; i < 8; ++i) { gk[i] = FOLD ? gain[k0 + 8 * c + i] : 1.f; bk[i] = FOLD ? lbias[k0 + 8 * c + i] : 0.f; }
#pragma unroll
    for (int j = 0; j < 4; ++j) { const int n = (lane >> 3) + 8 * j; const LAS float* s = scr + (8 * c) * 33 + n;
        float v[8];
#pragma unroll
        for (int i = 0; i < 8; ++i) v[i] = s[i * 33];
        v4u o; o.x = cvt_pk(v[0] * gk[0], v[1] * gk[1]); o.y = cvt_pk(v[2] * gk[2], v[3] * gk[3]); o.z = cvt_pk(v[4] * gk[4], v[5] * gk[5]); o.w = cvt_pk(v[6] * gk[6], v[7] * gk[7]);
        *(GAS v4u*)(WT + (size_t)(n0 + n) * K + k0 + 8 * c) = o;
        if (FOLD) {
            float cs = 0.f, cbs = 0.f;
#pragma unroll
            for (int i = 0; i < 4; ++i) { cs += __uint_as_float(o[i] << 16) + __uint_as_float(o[i] & 0xffff0000u); }
#pragma unroll
            for (int i = 0; i < 8; ++i) cbs += bk[i] * v[i];
            cs += __shfl_xor(cs, 1); cs += __shfl_xor(cs, 2); cs += __shfl_xor(cs, 4);
            cbs += __shfl_xor(cbs, 1); cbs += __shfl_xor(cbs, 2); cbs += __shfl_xor(cbs, 4);
            if (c == 0) { csp[(size_t)kb * N + n0 + n] = cs; cbp[(size_t)kb * N + n0 + n] = cbs; }
        } }
    LDS_WAIT(); asm volatile("" ::: "memory");
}

struct Args { const float* in[15]; float* out; unsigned char* ws; int ph_lo, ph_hi; };
__global__ void __launch_bounds__(NWAVES * 64, 2) hybrid_fwd(Args args) {
    extern __shared__ __attribute__((aligned(16))) unsigned char lds[];
    Frame F;
    F.lds = (LAS unsigned char*)lds;
    F.MISC = (volatile LAS unsigned*)(F.lds + MISC_OFF);
    F.tid = threadIdx.x; F.lane = F.tid & 63; F.wave = __builtin_amdgcn_readfirstlane(F.tid >> 6);
    F.G = gridDim.x; { const int bx = blockIdx.x; F.vcu = (F.G % 8 == 0) ? (bx % 8) * (F.G / 8) + bx / 8 : bx; }
    unsigned char* ws = args.ws;
    F.ctl = (gu32*)(ws + WS_CTL);
    const float* x = args.in[0]; const float* attn_w_in = args.in[1]; const float* attn_w_out = args.in[2]; const float* rel_bias = args.in[3];
    const float* lru_w_in = args.in[4]; const float* conv_w = args.in[5]; const float* conv_b = args.in[6]; const float* lru_wa = args.in[7]; const float* lru_ba = args.in[8];
    const float* lru_wx = args.in[9]; const float* lru_bx = args.in[10]; const float* lru_lam = args.in[11]; const float* lru_w_out = args.in[12];
    const float* ln_gain = args.in[13]; const float* ln_bias = args.in[14];
    float* out = args.out;
    bf16* W1t = (bf16*)(ws + WS_W1T); bf16* W2t = (bf16*)(ws + WS_W2T); bf16* W3t = (bf16*)(ws + WS_W3T); bf16* W4t = (bf16*)(ws + WS_W4T);
    float* csp = (float*)(ws + WS_CSP); float* cbp = (float*)(ws + WS_CBP); float* csum = (float*)(ws + WS_CSUM); float* cbv = (float*)(ws + WS_CB);
    pg8::f32x2e* st0 = (pg8::f32x2e*)(ws + WS_ST0); pg8::f32x2e* part = (pg8::f32x2e*)(ws + WS_PART);
    bf16* R0 = (bf16*)(ws + WS_R0); bf16* R1 = (bf16*)(ws + WS_R1); bf16* R2 = (bf16*)(ws + WS_R2); bf16* R3 = (bf16*)(ws + WS_R3); bf16* R4 = (bf16*)(ws + WS_R4);
    float* Z0 = (float*)(ws + WS_R1);

    for (int u = F.tid; u < (LDS_BYTES - LDSCTL_OFF) / 4; u += NWAVES * 64) ((LAS unsigned*)(F.lds + LDSCTL_OFF))[u] = 0u;
    __syncthreads();
    XcdBarrier bar = xcd_barrier_post((unsigned*)(F.ctl + CW_BAR), F.MISC + 8);
    const int lo = args.ph_lo, hi = args.ph_hi;
#define IN(k) (lo <= (k) && (k) < hi)
#define GRID_BAR() xcd_barrier(bar)
    const int gw = F.vcu * NWAVES + F.wave, NGW = F.G * NWAVES;

    if (IN(0)) {
        LAS float* scr = (LAS float*)(F.lds + RING_OFF + F.wave * 16384);
        constexpr int I1 = (DM / 64) * (N1 / 32), I2 = (DM / 64) * (DM / 32), I3 = (DM / 64) * (N3 / 32), I4 = I2, NITEMS = I1 + I2 + I3 + I4;
        for (int it = gw; it < NITEMS; it += NGW) {
            int r = it;
            if (r < I1) { p0_transpose_item<false>(attn_w_in, DM, N1, W1t, scr, r, F.lane, nullptr, nullptr, nullptr, nullptr); continue; } r -= I1;
            if (r < I2) { p0_transpose_item<false>(attn_w_out, DM, DM, W2t, scr, r, F.lane, nullptr, nullptr, nullptr, nullptr); continue; } r -= I2;
            if (r < I3) { p0_transpose_item<true>(lru_w_in, DM, N3, W3t, scr, r, F.lane, ln_gain, ln_bias, csp, cbp); continue; } r -= I3;
            p0_transpose_item<false>(lru_w_out, DM, DM, W4t, scr, r, F.lane, nullptr, nullptr, nullptr, nullptr);
        }
        { const GAS f32x4* x4 = (const GAS f32x4*)x; GAS v4u* xb = (GAS v4u*)R0; const size_t n8 = (size_t)M * DM / 8;
          for (size_t i = (size_t)gw * 64 + F.lane; i < n8; i += (size_t)NGW * 64) { const f32x4 a = x4[2 * i], b = x4[2 * i + 1];
              v4u o; o.x = cvt_pk(a.x, a.y); o.y = cvt_pk(a.z, a.w); o.z = cvt_pk(b.x, b.y); o.w = cvt_pk(b.z, b.w); xb[i] = o; } }
        GRID_BAR();
    }
    if (IN(1)) {
        pg8::Gemm g{R0, W1t, M, N1, DM}; pg8::StaticOrder S; S.init(M, N1, F.G, (int)blockIdx.x);
        pg8::EpiBf16<0> E{R1, DM, nullptr, DM, (size_t)(WS_R2 - WS_R1) / 2, QSCALE};
        pg8::gemm_phase<pg8::EpiBf16<0>, pg8::StaticOrder, true, true>(F.lds + RING_OFF, g, S, E);
        GRID_BAR();
    }
    if (IN(2)) {
        const att::Tensors T{R1, R2, R3, R4, R0, rel_bias};
        for (int bh = F.vcu; bh < BATCH * NH; bh += F.G) att::attn_bh(F.lds + RING_OFF, (LAS float*)(F.lds + TL_OFF), T, bh / NH, bh % NH);
        GRID_BAR();
    }
    if (IN(3)) {
        pg8::Gemm g{R0, W2t, M, DM, DM}; pg8::StaticOrder S; S.init(M, DM, F.G, (int)blockIdx.x);
        pg8::EpiRes0 E{x, Z0, R3, part, DM, M, DN_ALPHA};
        pg8::gemm_phase<pg8::EpiRes0, pg8::StaticOrder, true, true>(F.lds + RING_OFF, g, S, E);
        GRID_BAR();
    }
    if (IN(4)) {
        const int gt = F.vcu * (NWAVES * 64) + F.tid, NGT = F.G * NWAVES * 64;
        for (int r = gt; r < M + N3; r += NGT) {
            if (r < M) { float s = 0.f, q = 0.f;
#pragma unroll 8
                for (int p = 0; p < 32; ++p) { const pg8::f32x2e v = part[(size_t)p * M + r]; s += v.x; q += v.y; }
                const float mean = s * (1.0f / DM), var = q * (1.0f / DM) - mean * mean;
                st0[r] = (pg8::f32x2e){mean, 1.0f / sqrtf(var + LN_EPS)};
            } else { const int n = r - M; float a = 0.f, b = 0.f;
#pragma unroll 8
                for (int kb = 0; kb < 32; ++kb) { a += csp[(size_t)kb * N3 + n]; b += cbp[(size_t)kb * N3 + n]; }
                csum[n] = a; cbv[n] = b; }
        }
        GRID_BAR();
    }
    if (IN(5)) {
        pg8::Gemm g{R3, W3t, M, N3, DM}; pg8::StaticOrder S; S.init(M, N3, F.G, (int)blockIdx.x);
        pg8::EpiLnFold E{R0, DM, st0, csum, cbv, DM, (size_t)(WS_R4 - WS_R0) / 2};
        pg8::gemm_phase<pg8::EpiLnFold, pg8::StaticOrder, true, true>(F.lds + RING_OFF, g, S, E);
        GRID_BAR();
    }
    if (IN(6)) {
        const lru::Params P{R0, R4, R3, conv_w, conv_b, lru_wa, lru_ba, lru_wx, lru_bx, lru_lam};
        for (int bn = F.vcu; bn < BATCH * 16; bn += F.G) lru::lru_bn(F.lds + RING_OFF, P, bn / 16, bn % 16);
        GRID_BAR();
    }
    if (IN(7)) {
        pg8::Gemm g{R3, W4t, M, DM, DM}; pg8::StaticOrder S; S.init(M, DM, F.G, (int)blockIdx.x);
        pg8::EpiRes1 E{Z0, st0, ln_gain, ln_bias, out, part, DM, M, DN_ALPHA};
        pg8::gemm_phase<pg8::EpiRes1, pg8::StaticOrder, true, true>(F.lds + RING_OFF, g, S, E);
        GRID_BAR();
    }
    if (IN(8)) {
        const unsigned bad = (__hip_atomic_load(F.ctl + CW_BAR + XB_TMO, RLX_AGENT) != 0u);
        f32x4 gv[8], bv[8];
#pragma unroll
        for (int j = 0; j < 8; ++j) { gv[j] = *(const f32x4*)(ln_gain + DM + 4 * F.lane + 256 * j); bv[j] = *(const f32x4*)(ln_bias + DM + 4 * F.lane + 256 * j); }
        for (int r = gw; r < M; r += NGW) {
            float s = 0.f, q = 0.f;
            if (F.lane < 32) { const pg8::f32x2e v = part[(size_t)F.lane * M + r]; s = v.x; q = v.y; }
            s = wave_sum(s); q = wave_sum(q);
            const float mean = s * (1.0f / DM), var = q * (1.0f / DM) - mean * mean; float rstd = 1.0f / sqrtf(var + LN_EPS);
            if (bad) rstd = __builtin_nanf("");
            GAS f32x4* o4 = (GAS f32x4*)(out + (size_t)r * DM) + F.lane;
            f32x4 v[8];
#pragma unroll
            for (int j = 0; j < 8; ++j) v[j] = o4[64 * j];
#pragma unroll
            for (int j = 0; j < 8; ++j) o4[64 * j] = ((v[j] - mean) * rstd) * gv[j] + bv[j];
        }
    }
#undef IN
#undef GRID_BAR
}

extern "C" void kernel_launch(void* const* d_in, const int* in_sizes, int n_in, void* d_out, int out_size, void* d_ws, size_t ws_size, hipStream_t stream) {
    static int grid = 0;
    if (grid == 0) {
        if (n_in != 15 || in_sizes[0] != M * DM || out_size != M * DM || ws_size < WS_END) {
            fprintf(stderr, "kernel_launch: built for 15 inputs, x/out of %d floats, >= %zu bytes of workspace; got n_in %d in0 %d out %d ws %zu\n", M * DM, (size_t)WS_END, n_in, n_in > 0 ? in_sizes[0] : -1, out_size, ws_size);
            grid = -1; return; }
        int dev = 0, cus = 0;
        if (hipGetDevice(&dev) != hipSuccess || hipDeviceGetAttribute(&cus, hipDeviceAttributeMultiprocessorCount, dev) != hipSuccess) { grid = -1; return; }
        if (hipFuncSetAttribute((const void*)hybrid_fwd, hipFuncAttributeMaxDynamicSharedMemorySize, LDS_BYTES) != hipSuccess) { fprintf(stderr, "kernel_launch: hipFuncSetAttribute failed\n"); grid = -1; return; }
        (void)hipGetLastError();
        grid = cus;
        if (grid != 256) fprintf(stderr, "kernel_launch: note: %d CUs (tuned for 256)\n", grid);
    }
    if (grid < 0) return;
    if (hipMemsetAsync((char*)d_ws + WS_CTL, 0, CTL_ZERO_BYTES, stream) != hipSuccess) { fprintf(stderr, "kernel_launch: hipMemsetAsync failed\n"); return; }
    Args a{};
    for (int i = 0; i < 15; ++i) a.in[i] = (const float*)d_in[i];
    a.out = (float*)d_out; a.ws = (unsigned char*)d_ws; a.ph_lo = 0; a.ph_hi = 9;
    hipLaunchKernelGGL(hybrid_fwd, dim3(grid), dim3(NWAVES * 64), LDS_BYTES, stream, a);
    const hipError_t le = hipPeekAtLastError();
    if (le != hipSuccess) fprintf(stderr, "kernel_launch: launch failed: %s\n", hipGetErrorName(le));
}
```

```cpp
#include <hip/hip_runtime.h>
#include <cstdio>
#include <cstdint>
__device__ __forceinline__ int lane_id_mb() { int l; asm volatile("v_mbcnt_lo_u32_b32 %0, -1, 0\n\tv_mbcnt_hi_u32_b32 %0, -1, %0" : "=v"(l)); return l; }
__device__ __forceinline__ int wg_tid(int wave_s) { return wave_s * 64 + lane_id_mb(); }
namespace pg8 {
#define PG8_LAS __attribute__((address_space(3)))
typedef unsigned short bf16_t;
typedef short bf16x8 __attribute__((ext_vector_type(8)));
typedef float f32x4 __attribute__((ext_vector_type(4)));
typedef unsigned u32x4 __attribute__((ext_vector_type(4)));
constexpr int BM = 256, BK = 64, HALF = 128, HTB = HALF * BK * 2  , STAGE_BYTES = 8 * HTB, NXCD = 8, WGM = 8;

__host__ __device__ __forceinline__ int lds_byte(int r, int c) { const int st = (r >> 4) * 2 + (c >> 5), rr = r & 15, cc = c & 31, ob = rr * 64 + cc * 2; return st * 1024 + (ob ^ (((ob >> 9) & 1) << 5)); }
__host__ __device__ __forceinline__ void stage_rc(int b, int& R, int& C) { const int st = b / 1024, sb = b % 1024, swz = sb ^ (((sb >> 9) & 1) << 5); R = (st >> 1) * 16 + swz / 64; C = (st & 1) * 32 + (swz % 64) / 2; }
__host__ __device__ __forceinline__ int perm32(int rho) { const int n = rho >> 4, i = rho & 15; return 8 * (i >> 2) + 4 * n + (i & 3); }

struct Unit { int pm, pn; };
struct Gemm { const bf16_t* A; const bf16_t* Bt; int M, N, K; int sA, sB; };
typedef int i32x4 __attribute__((ext_vector_type(4)));
typedef int i32x8 __attribute__((ext_vector_type(8)));
__device__ __forceinline__ i32x8 cat8(bf16x8 lo, bf16x8 hi) { return __builtin_shufflevector(__builtin_bit_cast(i32x4, lo), __builtin_bit_cast(i32x4, hi), 0, 1, 2, 3, 4, 5, 6, 7); }

struct StaticOrder {
    int nM, nN, nwg, G, c;
    __host__ __device__ void init(int M, int N, int G_, int c_) { nM = M / BM; nN = N / BM; nwg = nM * nN; G = G_; c = c_; }
    __host__ __device__ bool next(int i, Unit& u) const {
        const long L = (long)i * G + c; if (L >= nwg) return false;
        int wgid = (int)L; { const int q = nwg / NXCD, r = nwg % NXCD, xcd = wgid % NXCD, off = wgid / NXCD; wgid = (xcd < r ? xcd * (q + 1) : r * (q + 1) + (xcd - r) * q) + off; }
        const int nig = WGM * nN, gid = wgid / nig, fm = gid * WGM, gsz = (nM - fm) < WGM ? (nM - fm) : WGM;
        u.pm = fm + ((wgid % nig) % gsz); u.pn = (wgid % nig) / gsz; return true;
    }
    __device__ __forceinline__ void a_ready(const Unit&) const {}
    __device__ __forceinline__ void done(const Unit&) const {}
};

__device__ __forceinline__ unsigned cvt_pk_bf16(float lo, float hi) { unsigned r; asm volatile("v_cvt_pk_bf16_f32 %0, %1, %2" : "=v"(r) : "v"(lo), "v"(hi)); return r; }
template <int ACT  > struct EpiBf16 {
    static constexpr bool PERM = true, AFTER_DRAIN = false; static constexpr int EPI_STORES = 16  ; static_assert(ACT == 0, "EpiBf16: ACT is 0 (none)");
    bf16_t* O; int ldc; const float* bias; int split_cols; size_t split_stride; float scale0; int act_tile; int q8_tiles; int roff  ;
    __device__ __forceinline__ void operator()(const f32x4 (&acc)[2][2][4][2], const Unit& u, int wr, int wc, int fr, int fq) const {
        const int row0 = roff + u.pm * BM + wr * 64 + fr; int colt = u.pn * BM; bf16_t* base = O;
        float sc = 1.f; bool act = false, f8 = false; if (split_cols) { const int t = colt / split_cols; base += (size_t)t * split_stride; colt -= t * split_cols; if (t == 0) sc = scale0; if (t == 2 && q8_tiles > 2) sc = 8.0f; act = (t == act_tile); f8 = (t < q8_tiles); }
        const int col0 = colt + wc * 32 + 8 * fq, bcol0 = u.pn * BM + wc * 32 + 8 * fq;
        f32x4 bv[2][2];
#pragma unroll
        for (int bj = 0; bj < 2; ++bj)
#pragma unroll
            for (int n = 0; n < 2; ++n) bv[bj][n] = (f32x4){0.f, 0.f, 0.f, 0.f};
        if (f8) {
            unsigned char* b8 = (unsigned char*)base + (size_t)(row0 + ((fq & 1) ? 16 : 0)) * ldc + (col0 - ((fq & 1) ? 8 : 0));
#pragma unroll
            for (int ai = 0; ai < 2; ++ai)
#pragma unroll
                for (int bj = 0; bj < 2; ++bj)
#pragma unroll
                    for (int mp = 0; mp < 2; ++mp) { int wa0 = 0, wa1 = 0, wb0 = 0, wb1 = 0;
                        { const f32x4 v0 = acc[ai][bj][2 * mp][0] * sc, v1 = acc[ai][bj][2 * mp][1] * sc;
                          wa0 = __builtin_amdgcn_cvt_pk_fp8_f32(v0[0], v0[1], wa0, false); wa0 = __builtin_amdgcn_cvt_pk_fp8_f32(v0[2], v0[3], wa0, true);
                          wa1 = __builtin_amdgcn_cvt_pk_fp8_f32(v1[0], v1[1], wa1, false); wa1 = __builtin_amdgcn_cvt_pk_fp8_f32(v1[2], v1[3], wa1, true); }
                        { const f32x4 v0 = acc[ai][bj][2 * mp + 1][0] * sc, v1 = acc[ai][bj][2 * mp + 1][1] * sc;
                          wb0 = __builtin_amdgcn_cvt_pk_fp8_f32(v0[0], v0[1], wb0, false); wb0 = __builtin_amdgcn_cvt_pk_fp8_f32(v0[2], v0[3], wb0, true);
                          wb1 = __builtin_amdgcn_cvt_pk_fp8_f32(v1[0], v1[1], wb1, false); wb1 = __builtin_amdgcn_cvt_pk_fp8_f32(v1[2], v1[3], wb1, true); }
                        const auto r0 = __builtin_amdgcn_permlane16_swap((unsigned)wa0, (unsigned)wb0, false, false), r1 = __builtin_amdgcn_permlane16_swap((unsigned)wa1, (unsigned)wb1, false, false);
                        *(u32x4*)(b8 + (size_t)(ai * HALF + 32 * mp) * ldc + bj * HALF) = (u32x4){r0[0], r1[0], r0[1], r1[1]}; }
            return; }
#pragma unroll
        for (int ai = 0; ai < 2; ++ai)
#pragma unroll
            for (int m = 0; m < 4; ++m) { bf16_t* rowp = base + (size_t)(row0 + ai * HALF + m * 16) * ldc + col0;
#pragma unroll
                for (int bj = 0; bj < 2; ++bj) { f32x4 v0 = acc[ai][bj][m][0] + bv[bj][0], v1 = acc[ai][bj][m][1] + bv[bj][1];
                    if (act) {
#pragma unroll
                        for (int j = 0; j < 4; ++j) { v0[j] = v0[j] * __builtin_amdgcn_rcpf(1.0f + __builtin_amdgcn_exp2f(-1.4426950408889634f * v0[j])); v1[j] = v1[j] * __builtin_amdgcn_rcpf(1.0f + __builtin_amdgcn_exp2f(-1.4426950408889634f * v1[j])); } }
                    { u32x4 w; w.x = cvt_pk_bf16(v0[0], v0[1]); w.y = cvt_pk_bf16(v0[2], v0[3]); w.z = cvt_pk_bf16(v1[0], v1[1]); w.w = cvt_pk_bf16(v1[2], v1[3]);
                        *(u32x4*)(rowp + bj * HALF) = w; } } }
    }
};
template <class Epi, class Sched, bool ALIGN_EPI = false, bool SP2 = false, bool FP8 = false>
__device__ __forceinline__ void gemm_phase(PG8_LAS unsigned char* lds, const Gemm g, const Sched& S, const Epi& E, int wv) {
    int tid_ = wg_tid(wv); asm volatile("" : "+v"(tid_));
    const int tid = tid_, wid = __builtin_amdgcn_readfirstlane(tid >> 6), lane = tid & 63, wr = wid >> 2, wc = wid & 3, fr = lane & 15, fq = lane >> 4;
    const int K = g.K, nt = K / BK;
    unsigned voffA[2], voffB[2];
#pragma unroll
    for (int i = 0; i < 2; ++i) { int R, C; stage_rc(tid * 16 + i * 8192, R, C); const int Rb = Epi::PERM ? ((R & ~31) + perm32(R & 31)) : R;
        voffA[i] = (unsigned)(R * K + C) * 2u; voffB[i] = (unsigned)(Rb * K + C) * 2u; }
    const unsigned rstep64 = 64u * (unsigned)K * 2u;
    const unsigned kstep = (unsigned)(BK * 2);
    const unsigned hstep = (unsigned)HALF * K * 2;
    const unsigned tstep = 2 * hstep;
    const unsigned ldsw = (unsigned)wid * 1024u;
    const int aoff = lds_byte(wr * 64 + fr, fq * 8), boff = lds_byte(wc * 32 + fr, fq * 8);
#define PG8_SA(b, h) (((b) * 2 + (h)) * HTB)
#define PG8_SB(b, h) ((4 + (b) * 2 + (h)) * HTB)
#define PG8_STAGE(bufoff, goff, voff) do { _Pragma("unroll") for (int _i = 0; _i < 2; ++_i) \
        __builtin_amdgcn_raw_ptr_buffer_load_lds((&(voff)[0] == &voffA[0]) ? rA : rB, (PG8_LAS void*)(lds + (bufoff) + ldsw + _i * 8192), 16, (int)(voff)[0], (int)((goff) + (unsigned)_i * rstep64), 0, 0); } while (0)
#define PG8_LDA(dst, b, h) do { _Pragma("unroll") for (int m = 0; m < 4; ++m) { if constexpr (FP8) dst##8[m] = cat8(*(const PG8_LAS bf16x8*)(lds + PG8_SA(b, h) + aoff + m * 2048), *(const PG8_LAS bf16x8*)(lds + PG8_SA(b, h) + aoff + m * 2048 + 1024)); \
        else { _Pragma("unroll") for (int k = 0; k < 2; ++k) dst[m][k] = *(const PG8_LAS bf16x8*)(lds + PG8_SA(b, h) + aoff + m * 2048 + k * 1024); } } } while (0)
#define PG8_LDB(dst, b, h) do { _Pragma("unroll") for (int n = 0; n < 2; ++n) { if constexpr (FP8) dst##8[n] = cat8(*(const PG8_LAS bf16x8*)(lds + PG8_SB(b, h) + boff + n * 2048), *(const PG8_LAS bf16x8*)(lds + PG8_SB(b, h) + boff + n * 2048 + 1024)); \
        else { _Pragma("unroll") for (int k = 0; k < 2; ++k) dst[n][k] = *(const PG8_LAS bf16x8*)(lds + PG8_SB(b, h) + boff + n * 2048 + k * 1024); } } } while (0)
#define PG8_MMA(ai, bj, At, Bt) do { __builtin_amdgcn_s_setprio(1); _Pragma("unroll") for (int m = 0; m < 4; ++m) _Pragma("unroll") for (int n = 0; n < 2; ++n) { \
        if constexpr (FP8) acc[ai][bj][m][n] = __builtin_amdgcn_mfma_scale_f32_16x16x128_f8f6f4(Bt##8[n], At##8[m], acc[ai][bj][m][n], 0, 0, 0, g.sB, 0, g.sA); \
        else { _Pragma("unroll") for (int k = 0; k < 2; ++k) acc[ai][bj][m][n] = __builtin_amdgcn_mfma_f32_16x16x32_bf16(Bt[n][k], At[m][k], acc[ai][bj][m][n], 0, 0, 0); } } __builtin_amdgcn_s_setprio(0); } while (0)
#define PG8_WAIT_V(n) asm volatile("s_waitcnt vmcnt(" #n ")" ::: "memory")
#define PG8_WAIT_L(n) asm volatile("s_waitcnt lgkmcnt(" #n ")" ::: "memory")
#define PG8_BAR __builtin_amdgcn_s_barrier()
#define PG8_SCHED __builtin_amdgcn_sched_barrier(0)
    Unit cur, nxt; int ui = 0;
    if (!S.next(0, cur)) return;
    f32x4 acc[2][2][4][2];
#pragma unroll
    for (int a = 0; a < 2; ++a)
#pragma unroll
        for (int b = 0; b < 2; ++b)
#pragma unroll
            for (int m = 0; m < 4; ++m)
#pragma unroll
                for (int n = 0; n < 2; ++n) acc[a][b][m][n] = (f32x4){0.f, 0.f, 0.f, 0.f};
    bf16x8 At[4][2], B0[2][2], B1[2][2]; i32x8 At8[4], B08[2], B18[2];
    const __amdgpu_buffer_rsrc_t rA = __builtin_amdgcn_make_buffer_rsrc((void*)g.A, 0, (int)((unsigned)g.M * (unsigned)K * 2u), 0x00020000), rB = __builtin_amdgcn_make_buffer_rsrc((void*)g.Bt, 0, (int)((unsigned)g.N * (unsigned)K * 2u), 0x00020000);
    unsigned cA = (unsigned)cur.pm * tstep, cB = (unsigned)cur.pn * tstep;
    S.a_ready(cur);
    if constexpr (SP2) {
        PG8_STAGE(PG8_SB(0, 0), cB, voffB); PG8_STAGE(PG8_SB(0, 1), cB + hstep, voffB); PG8_STAGE(PG8_SA(0, 0), cA, voffA); PG8_STAGE(PG8_SA(0, 1), cA + hstep, voffA);
        if (wr == 1) PG8_BAR;
        PG8_WAIT_V(2); PG8_BAR;
        PG8_STAGE(PG8_SB(1, 0), cB + kstep, voffB); PG8_STAGE(PG8_SA(1, 0), cA + kstep, voffA); PG8_STAGE(PG8_SB(1, 1), cB + hstep + kstep, voffB);
        PG8_WAIT_V(6); PG8_BAR;
    } else {
        PG8_STAGE(PG8_SB(0, 0), cB, voffB); PG8_STAGE(PG8_SA(0, 0), cA, voffA); PG8_STAGE(PG8_SB(0, 1), cB + hstep, voffB); PG8_STAGE(PG8_SA(0, 1), cA + hstep, voffA);
        if (wr == 1) PG8_BAR;
        PG8_WAIT_V(4); PG8_BAR;
        PG8_STAGE(PG8_SB(1, 0), cB + kstep, voffB); PG8_STAGE(PG8_SA(1, 0), cA + kstep, voffA); PG8_STAGE(PG8_SB(1, 1), cB + hstep + kstep, voffB);
        PG8_WAIT_V(6); PG8_BAR;
    }
    for (;;) {
        const bool has_next = S.next(ui + 1, nxt);
        const unsigned nA = has_next ? (unsigned)nxt.pm * tstep : cA, nB = has_next ? (unsigned)nxt.pn * tstep : cB;
        for (int t = 0; t < nt; t += 2) {
            const bool last = (t == nt - 2);
            const unsigned a1 = cA + (unsigned)(t + 1) * kstep;
            const unsigned a2 = last ? nA : cA + (unsigned)(t + 2) * kstep, b2 = last ? nB : cB + (unsigned)(t + 2) * kstep;
            const unsigned a3 = a2 + kstep, b3 = b2 + kstep;
            if (last && has_next) S.a_ready(nxt);
            if constexpr (SP2) {
            PG8_LDB(B0, 0, 0); PG8_LDB(B1, 0, 1); PG8_SCHED; PG8_LDA(At, 0, 0); PG8_STAGE(PG8_SA(1, 1), a1 + hstep, voffA);
            PG8_WAIT_V(8);
            PG8_WAIT_L(0); PG8_BAR; PG8_MMA(0, 0, At, B0); PG8_MMA(0, 1, At, B1); PG8_BAR; PG8_SCHED;
            PG8_LDA(At, 0, 1); PG8_STAGE(PG8_SB(0, 0), b2, voffB); PG8_STAGE(PG8_SB(0, 1), b2 + hstep, voffB); PG8_STAGE(PG8_SA(0, 0), a2, voffA);
            PG8_WAIT_V(8);
            PG8_WAIT_L(0); PG8_BAR; PG8_MMA(1, 0, At, B0); PG8_MMA(1, 1, At, B1); PG8_BAR; PG8_SCHED;
            PG8_LDB(B0, 1, 0); PG8_LDB(B1, 1, 1); PG8_SCHED; PG8_LDA(At, 1, 0); PG8_STAGE(PG8_SA(0, 1), a2 + hstep, voffA);
            PG8_WAIT_V(8); PG8_WAIT_L(0); PG8_BAR; PG8_MMA(0, 0, At, B0); PG8_MMA(0, 1, At, B1); PG8_BAR; PG8_SCHED;
            PG8_LDA(At, 1, 1); PG8_STAGE(PG8_SB(1, 0), b3, voffB); PG8_STAGE(PG8_SB(1, 1), b3 + hstep, voffB); PG8_STAGE(PG8_SA(1, 0), a3, voffA);
            PG8_WAIT_V(8); PG8_WAIT_L(0); PG8_BAR; PG8_MMA(1, 0, At, B0); PG8_MMA(1, 1, At, B1); PG8_BAR; PG8_SCHED;
            } else {
            PG8_LDB(B0, 0, 0); PG8_SCHED; PG8_LDA(At, 0, 0); PG8_STAGE(PG8_SA(1, 1), a1 + hstep, voffA);
            PG8_WAIT_L(8); PG8_BAR; PG8_WAIT_L(0); PG8_MMA(0, 0, At, B0); PG8_BAR; PG8_SCHED;
            PG8_LDB(B1, 0, 1); PG8_STAGE(PG8_SB(0, 0), b2, voffB);
            PG8_BAR; PG8_WAIT_L(0); PG8_MMA(0, 1, At, B1); PG8_BAR;
            PG8_LDA(At, 0, 1); PG8_STAGE(PG8_SA(0, 0), a2, voffA);
            PG8_BAR; PG8_WAIT_L(0); PG8_MMA(1, 0, At, B0); PG8_BAR; PG8_SCHED;
            PG8_STAGE(PG8_SB(0, 1), b2 + hstep, voffB);
            PG8_WAIT_V(6); PG8_BAR; PG8_MMA(1, 1, At, B1); PG8_BAR;
            PG8_LDB(B0, 1, 0); PG8_SCHED; PG8_LDA(At, 1, 0); PG8_STAGE(PG8_SA(0, 1), a2 + hstep, voffA);
            PG8_WAIT_L(8); PG8_BAR; PG8_WAIT_L(0); PG8_MMA(0, 0, At, B0); PG8_BAR; PG8_SCHED;
            PG8_LDB(B1, 1, 1); PG8_STAGE(PG8_SB(1, 0), b3, voffB);
            PG8_BAR; PG8_WAIT_L(0); PG8_MMA(0, 1, At, B1); PG8_BAR;
            PG8_LDA(At, 1, 1); PG8_STAGE(PG8_SA(1, 0), a3, voffA);
            PG8_BAR; PG8_WAIT_L(0); PG8_MMA(1, 0, At, B0); PG8_BAR; PG8_SCHED;
            PG8_STAGE(PG8_SB(1, 1), b3 + hstep, voffB);
            PG8_WAIT_V(6); PG8_BAR; PG8_MMA(1, 1, At, B1); PG8_BAR;
            }
        }
        if constexpr (ALIGN_EPI) { if (wr == 0) PG8_BAR; }
        if constexpr (!Epi::AFTER_DRAIN) { const int ln_ = lane_id_mb(); E(acc, cur, wr, wc, ln_ & 15, ln_ >> 4); S.done(cur); }
        if (!has_next) break;
#pragma unroll
        for (int a = 0; a < 2; ++a)
#pragma unroll
            for (int b = 0; b < 2; ++b)
#pragma unroll
                for (int m = 0; m < 4; ++m)
#pragma unroll
                    for (int n = 0; n < 2; ++n) acc[a][b][m][n] = (f32x4){0.f, 0.f, 0.f, 0.f};
        cur = nxt; cA = nA; cB = nB; ++ui;
        if constexpr (ALIGN_EPI) { if (wr == 1) PG8_BAR; }
    }
    PG8_WAIT_V(0);
    if constexpr (!ALIGN_EPI) { if (wr == 0) PG8_BAR; }
    PG8_BAR;
    if constexpr (Epi::AFTER_DRAIN) { E.fused(acc, cur, wr, wc, fr, fq, lds, wid, lane); S.done(cur); }
#undef PG8_SA
#undef PG8_SB
#undef PG8_STAGE
#undef PG8_LDA
#undef PG8_LDB
#undef PG8_MMA
#undef PG8_WAIT_V
#undef PG8_WAIT_L
#undef PG8_BAR
#undef PG8_SCHED
}
}

namespace att {
typedef short bf16x8 __attribute__((ext_vector_type(8)));
typedef short s16x4 __attribute__((ext_vector_type(4)));
typedef float f32x16 __attribute__((ext_vector_type(16)));
typedef float f32x4a __attribute__((ext_vector_type(4)));
typedef unsigned u32x4 __attribute__((ext_vector_type(4)));
typedef unsigned u32x2 __attribute__((ext_vector_type(2)));
#define ATT_LAS __attribute__((address_space(3)))
constexpr int SEQ = 2048, PITCH = 2048, NQG = 8;
typedef int i32x8a __attribute__((ext_vector_type(8)));
__device__ __forceinline__ i32x8a cat4(long a, long b, long c, long d) { return (i32x8a){(int)a, (int)(a >> 32), (int)b, (int)(b >> 32), (int)c, (int)(c >> 32), (int)d, (int)(d >> 32)}; }
constexpr int KVB = 16384;
constexpr int KB8 = 8192;
constexpr int LDS_V = 0, LDS_K = 8 * KB8;
constexpr int STG_STRIDE = 272, STG_WAVE = 32 * STG_STRIDE;
constexpr int TL_N = 640;
constexpr float THR = 6.0f;
__device__ __forceinline__ unsigned cvtpk(float lo, float hi) { unsigned r; asm volatile("v_cvt_pk_bf16_f32 %0, %1, %2" : "=v"(r) : "v"(lo), "v"(hi)); return r; }
__device__ __forceinline__ int kswz(int row, int colB) { return row * 256 + (colB ^ ((row & 7) << 4)); }
__device__ __forceinline__ int v_st(int k, int c) { return ((k >> 3) * 4 + (c >> 5)) * 512 + ((k & 7) * 32 + (c & 31)) * 2; }
__device__ __forceinline__ int v_rd_base(int lane) { return ((lane & 3) << 3) | (((lane >> 2) & 3) << 6) | (((lane >> 4) & 1) << 5) | (((lane >> 5) & 1) << 8); }
typedef short v4i16_t __attribute__((ext_vector_type(4)));
__device__ __forceinline__ s16x4 vtr(const ATT_LAS char* p) { return __builtin_bit_cast(s16x4, __builtin_amdgcn_ds_read_tr16_b64_v4i16((ATT_LAS v4i16_t*)p)); }
#define ATT_PK(L, H) (bf16x8){L[0], L[1], L[2], L[3], H[0], H[1], H[2], H[3]}
template <int OFF> __device__ __forceinline__ s16x4 tr_read(int vb) { s16x4 r; asm volatile("ds_read_b64_tr_b16 %0, %1 offset:%2" : "=&v"(r) : "v"(vb), "i"(OFF) : "memory"); return r; }
template <int D0> __device__ __forceinline__ void pv_one(f32x16& od, int vb, bf16x8 pb0, bf16x8 pb1, bf16x8 pb2, bf16x8 pb3) {
    const s16x4 l0 = tr_read<D0 * 512 + 0 * 4096>(vb), h0 = tr_read<D0 * 512 + 0 * 4096 + 2048>(vb), l1 = tr_read<D0 * 512 + 1 * 4096>(vb), h1 = tr_read<D0 * 512 + 1 * 4096 + 2048>(vb);
    const s16x4 l2 = tr_read<D0 * 512 + 2 * 4096>(vb), h2 = tr_read<D0 * 512 + 2 * 4096 + 2048>(vb), l3 = tr_read<D0 * 512 + 3 * 4096>(vb), h3 = tr_read<D0 * 512 + 3 * 4096 + 2048>(vb);
    asm volatile("s_waitcnt lgkmcnt(0)" ::: "memory"); __builtin_amdgcn_sched_barrier(0);
    od = __builtin_amdgcn_mfma_f32_32x32x16_bf16(ATT_PK(l0, h0), pb0, od, 0, 0, 0);
    od = __builtin_amdgcn_mfma_f32_32x32x16_bf16(ATT_PK(l1, h1), pb1, od, 0, 0, 0);
    od = __builtin_amdgcn_mfma_f32_32x32x16_bf16(ATT_PK(l2, h2), pb2, od, 0, 0, 0);
    od = __builtin_amdgcn_mfma_f32_32x32x16_bf16(ATT_PK(l3, h3), pb3, od, 0, 0, 0);
}
struct Tensors { const unsigned short* Q; const unsigned short* K; const unsigned short* V; const unsigned short* G; unsigned short* O; const float* table; };

__device__ __forceinline__ void attn_bh(ATT_LAS unsigned char* lds, ATT_LAS float* tl, const Tensors& T, int b, int h, int wv) {
    int tid_ = wg_tid(wv); asm volatile("" : "+v"(tid_));
    const int tid = tid_, lane = tid & 63, r32 = lane & 31, hi = lane >> 5; const int wid = __builtin_amdgcn_readfirstlane(tid >> 6);
    for (int e = tid; e < TL_N; e += 512) { int d = 575 - e; d = d > 256 ? 256 : d; d = d < -256 ? -256 : d; tl[e] = T.table[h * 513 + d + 256] * 1.4426950408889634f; }
    const int ci = wid < 4 ? wid : 7 - wid, hf = wid >> 2;
    const size_t rowb = (size_t)b * SEQ;
    const unsigned hbase = (unsigned)(rowb * PITCH + h * 128) * 2u;
    const __amdgpu_buffer_rsrc_t rK = __builtin_amdgcn_make_buffer_rsrc((void*)T.K, 0, (int)(32768u * PITCH), 0x00020000), rV = __builtin_amdgcn_make_buffer_rsrc((void*)T.V, 0, (int)(32768u * PITCH), 0x00020000);
    unsigned koff0, koff1, voff0, voff1;
    { const int l16 = lane & 15, rq = lane >> 4;
      { const int row = 8 * wid + (lane >> 3); koff0 = (unsigned)(row * PITCH + (((lane & 7) ^ ((row >> 1) & 7)) << 4)); koff1 = 0u; (void)l16; (void)rq; }
      { const int row = 8 * wid + (lane >> 3), c16 = lane & 7, fv = ((row >> 1) & 1) | (((row >> 3) & 1) << 1);
        voff0 = (unsigned)(row * PITCH + (((c16 & 1) | (((c16 >> 1) ^ fv) << 1)) << 4)); voff1 = 0u; } }
    int vbase8[4];
    { const int g_ = lane >> 4, i_ = lane & 15; const int q_ = i_ >> 1, p_ = i_ & 1; const int h_ = g_ >> 1, kr0 = q_ < 4 ? 4 * h_ + q_ : 8 + 4 * h_ + (q_ - 4), fv = ((kr0 >> 1) & 1) | (((kr0 >> 3) & 1) << 1);
#pragma unroll
      for (int d0 = 0; d0 < 4; ++d0) { vbase8[d0] = (int)(unsigned)(uintptr_t)(lds + LDS_V) + kr0 * 128 + ((d0 ^ fv) << 5) + 16 * (g_ & 1) + 8 * p_; asm volatile("" : "+v"(vbase8[d0])); } }
    int kbase[8];
#pragma unroll
    for (int j = 0; j < 8; ++j) { kbase[j] = r32 * 128 + ((j ^ ((r32 >> 1) & 7)) << 4) + 8 * hi; asm volatile("" : "+v"(kbase[j])); }
#define ATT_DMA(t, slot) do { const int so_ = (int)(hbase + (unsigned)(t) * (64u * PITCH * 2u)); \
        __builtin_amdgcn_raw_ptr_buffer_load_lds(rK, (ATT_LAS void*)(lds + LDS_K + (slot) * KB8 + 1024 * wid), 16, (int)koff0, (int)((unsigned)so_ >> 1), 0, 0); \
        __builtin_amdgcn_raw_ptr_buffer_load_lds(rV, (ATT_LAS void*)(lds + LDS_V + (slot) * KB8 + 1024 * wid), 16, (int)voff0, (int)((unsigned)so_ >> 1), 0, 0); } while (0)
#define ATT_BAR(N) do { asm volatile("s_waitcnt vmcnt(" #N ") lgkmcnt(0)" ::: "memory"); __builtin_amdgcn_s_barrier(); asm volatile("" ::: "memory"); } while (0)
    ATT_BAR(0);
    long qr[8];
#define ATT_QLOAD(qw0_) do { const unsigned char* Qw = (const unsigned char*)T.Q + (rowb + (qw0_) + r32) * PITCH + h * 128 + hi * 8; \
        _Pragma("unroll") for (int d0 = 0; d0 < 8; ++d0) qr[d0] = *(const long*)(Qw + d0 * 16); } while (0)
    ATT_QLOAD(ci * 64 + hf * 32); ATT_DMA(0, 0); ATT_DMA(1, 1); ATT_DMA(2, 2); ATT_DMA(3, 3);
#pragma unroll
    for (int d0 = 0; d0 < 8; ++d0) asm volatile("" : "+v"(qr[d0]));
    ATT_BAR(0);
    for (int qg = 0; qg < NQG; ++qg) {
        const int c0 = 4 * qg, t_lo = c0 - 8 > 0 ? c0 - 8 : 0, t_hi = c0 + 3;
        const int c = c0 + ci, my_lo = c - 8 > 0 ? c - 8 : 0, my_hi = c;
        const int qw0 = c * 64 + hf * 32;
        float m_reg = -1e30f, l_reg = 0.f; f32x16 o[4];
#pragma unroll
        for (int d = 0; d < 4; ++d)
#pragma unroll
            for (int r = 0; r < 16; ++r) o[d][r] = 0.f;
        const int D = c0 >= 8 ? 3 : 0, nsteps = (c0 + 3 < 8 ? c0 + 3 : 8) + 1, rmax = t_hi - t_lo;
        int next_r = 4;
        for (int jp = 0; jp < nsteps; jp += (jp == 0 ? 1 : 2)) {
            const int cnt = jp == 0 ? 1 : 2;
            for (; next_r <= rmax && next_r <= jp + 7; ++next_r) ATT_DMA(t_lo + next_r, next_r & 7);
          for (int u = 0; u < cnt; ++u) { const int j = jp + u; if (j >= nsteps) break; const int t = my_lo + j, slot = (t - t_lo) & 7;
            if (t >= my_lo && t <= my_hi) {
                const ATT_LAS float* tb = tl + (575 - (qw0 - t * 64) - r32 + 4 * hi);
                f32x16 p0, p1;
#pragma unroll
                for (int r = 0; r < 16; ++r) { p0[r] = tb[(r & 3) + 8 * (r >> 2)]; p1[r] = tb[32 + (r & 3) + 8 * (r >> 2)]; }
                const int kbo = slot * KB8;
                long kf0[8], kf1[8];
#pragma unroll
                for (int d0 = 0; d0 < 8; ++d0) { const ATT_LAS char* kp_ = (const ATT_LAS char*)lds + LDS_K + kbase[d0] + kbo;
                    kf0[d0] = *(const ATT_LAS long*)(kp_); kf1[d0] = *(const ATT_LAS long*)(kp_ + 4096); }
                __builtin_amdgcn_sched_barrier(0);
#pragma unroll
                for (int s = 0; s < 2; ++s) { const i32x8a qq = cat4(qr[4 * s], qr[4 * s + 1], qr[4 * s + 2], qr[4 * s + 3]);
                    p0 = __builtin_amdgcn_mfma_scale_f32_32x32x64_f8f6f4(cat4(kf0[4 * s], kf0[4 * s + 1], kf0[4 * s + 2], kf0[4 * s + 3]), qq, p0, 0, 0, 0, 0x7f7f7f7f, 0, 0x7f7f7f7f);
                    p1 = __builtin_amdgcn_mfma_scale_f32_32x32x64_f8f6f4(cat4(kf1[4 * s], kf1[4 * s + 1], kf1[4 * s + 2], kf1[4 * s + 3]), qq, p1, 0, 0, 0, 0x7f7f7f7f, 0, 0x7f7f7f7f); }
                __builtin_amdgcn_sched_barrier(0);
                float pmax = p0[0];
#pragma unroll
                for (int r = 1; r < 16; ++r) pmax = fmaxf(pmax, p0[r]);
#pragma unroll
                for (int r = 0; r < 16; ++r) pmax = fmaxf(pmax, p1[r]);
                { auto rr = __builtin_amdgcn_permlane32_swap(__float_as_uint(pmax), __float_as_uint(pmax), false, false); pmax = fmaxf(__uint_as_float(rr[0]), __uint_as_float(rr[1])); }
                if (!__all(pmax - m_reg <= THR)) {
                    const float mn = fmaxf(m_reg, pmax), alpha = __builtin_amdgcn_exp2f(m_reg - mn); m_reg = mn; l_reg *= alpha;
#pragma unroll
                    for (int d = 0; d < 4; ++d)
#pragma unroll
                        for (int r = 0; r < 16; ++r) o[d][r] *= alpha;
                }
                float ps0 = 0.f, ps1 = 0.f, ps2 = 0.f, ps3 = 0.f;
#pragma unroll
                for (int r = 0; r < 16; r += 4) { p0[r] = __builtin_amdgcn_exp2f(p0[r] - m_reg); ps0 += p0[r]; p0[r + 1] = __builtin_amdgcn_exp2f(p0[r + 1] - m_reg); ps1 += p0[r + 1];
                    p0[r + 2] = __builtin_amdgcn_exp2f(p0[r + 2] - m_reg); ps2 += p0[r + 2]; p0[r + 3] = __builtin_amdgcn_exp2f(p0[r + 3] - m_reg); ps3 += p0[r + 3]; }
#pragma unroll
                for (int r = 0; r < 16; r += 4) { p1[r] = __builtin_amdgcn_exp2f(p1[r] - m_reg); ps0 += p1[r]; p1[r + 1] = __builtin_amdgcn_exp2f(p1[r + 1] - m_reg); ps1 += p1[r + 1];
                    p1[r + 2] = __builtin_amdgcn_exp2f(p1[r + 2] - m_reg); ps2 += p1[r + 2]; p1[r + 3] = __builtin_amdgcn_exp2f(p1[r + 3] - m_reg); ps3 += p1[r + 3]; }
                l_reg += (ps0 + ps1) + (ps2 + ps3);
                long pb8[4];
#define ATT_PK8(P, B0) ({ int lo_ = 0, hi_ = 0; lo_ = __builtin_amdgcn_cvt_pk_fp8_f32(P[B0], P[B0 + 1], lo_, false); lo_ = __builtin_amdgcn_cvt_pk_fp8_f32(P[B0 + 2], P[B0 + 3], lo_, true); \
                    hi_ = __builtin_amdgcn_cvt_pk_fp8_f32(P[B0 + 4], P[B0 + 5], hi_, false); hi_ = __builtin_amdgcn_cvt_pk_fp8_f32(P[B0 + 6], P[B0 + 7], hi_, true); (long)(((unsigned long long)(unsigned)hi_ << 32) | (unsigned)lo_); })
                pb8[0] = ATT_PK8(p0, 0); pb8[1] = ATT_PK8(p0, 8); pb8[2] = ATT_PK8(p1, 0); pb8[3] = ATT_PK8(p1, 8);
#undef ATT_PK8
                const int vso = slot * KB8;
#pragma unroll
                for (int d0 = 0; d0 < 4; ++d0) { long vf[4];
#pragma unroll
                    for (int ks = 0; ks < 4; ++ks) asm volatile("ds_read_b64_tr_b8 %0, %1 offset:%2" : "=&v"(vf[ks]) : "v"(vbase8[d0] + vso), "i"(ks * 2048) : "memory");
                    asm volatile("s_waitcnt lgkmcnt(0)" ::: "memory"); __builtin_amdgcn_sched_barrier(0);
                    o[d0] = __builtin_amdgcn_mfma_scale_f32_32x32x64_f8f6f4(cat4(vf[0], vf[1], vf[2], vf[3]), cat4(pb8[0], pb8[1], pb8[2], pb8[3]), o[d0], 0, 0, 0, 0x7f7f7f7f, 0, 0x7f7f7f7f); }
            }
          }
            { const int jn = jp + cnt, need = jn + 1 + D < rmax ? jn + 1 + D : rmax; const int n = (next_r - 1) - need;
              if (n >= 4) ATT_BAR(8); else if (n == 3) ATT_BAR(6); else if (n == 2) ATT_BAR(4); else if (n == 1) ATT_BAR(2); else ATT_BAR(0); }
        }
        { auto rr = __builtin_amdgcn_permlane32_swap(__float_as_uint(l_reg), __float_as_uint(l_reg), false, false); l_reg = __uint_as_float(rr[0]) + __uint_as_float(rr[1]); }
        const float linv = 0.125f / l_reg;
        if (qg + 1 < NQG) { const int nt_lo = c0 + 4 - 8 > 0 ? c0 + 4 - 8 : 0;
            ATT_DMA(nt_lo, 0); ATT_DMA(nt_lo + 1, 1); ATT_DMA(nt_lo + 2, 2); ATT_DMA(nt_lo + 3, 3); ATT_QLOAD(qw0 + 256); }
        const size_t orow0 = rowb + qw0;
        u32x4 gv[8];
#pragma unroll
        for (int i = 0; i < 8; ++i) gv[i] = *(const u32x4*)(T.G + (orow0 + 4 * i + (lane >> 4)) * PITCH + h * 128 + (lane & 15) * 8);
        ATT_LAS unsigned char* stg = lds + (wid < 4 ? LDS_V + 4 * KB8 + wid * 8192 : LDS_K + 4 * KB8 + (wid - 4) * 8192);
#pragma unroll
        for (int d0 = 0; d0 < 4; ++d0)
#pragma unroll
            for (int rq = 0; rq < 4; ++rq) { u32x2 w; w.x = cvtpk(o[d0][4 * rq] * linv, o[d0][4 * rq + 1] * linv); w.y = cvtpk(o[d0][4 * rq + 2] * linv, o[d0][4 * rq + 3] * linv);
                *(ATT_LAS u32x2*)(stg + r32 * 256 + (((4 * d0 + rq) ^ (r32 & 15)) << 4) + 8 * hi) = w; }
        __builtin_amdgcn_fence(__ATOMIC_RELEASE, "wavefront"); asm volatile("s_waitcnt lgkmcnt(0)" ::: "memory");
#pragma unroll
        for (int i = 0; i < 8; ++i) { const int row = 4 * i + (lane >> 4), ch = lane & 15;
            const u32x4 ov = *(const ATT_LAS u32x4*)(stg + row * 256 + ((ch ^ (row & 15)) << 4));
            int r8[2] = {0, 0};
#pragma unroll
            for (int j = 0; j < 4; ++j) {
                const float o_lo = __uint_as_float(ov[j] << 16), o_hi = __uint_as_float(ov[j] & 0xffff0000u);
                const float g_lo = __uint_as_float(gv[i][j] << 16), g_hi = __uint_as_float(gv[i][j] & 0xffff0000u);
                const float s_lo = g_lo * __builtin_amdgcn_rcpf(1.0f + __builtin_amdgcn_exp2f(-1.4426950408889634f * g_lo));
                const float s_hi = g_hi * __builtin_amdgcn_rcpf(1.0f + __builtin_amdgcn_exp2f(-1.4426950408889634f * g_hi));
                const float e0 = o_lo * s_lo * 64.0f, e1 = o_hi * s_hi * 64.0f;
                if (j & 1) r8[j >> 1] = __builtin_amdgcn_cvt_pk_fp8_f32(e0, e1, r8[j >> 1], true); else r8[j >> 1] = __builtin_amdgcn_cvt_pk_fp8_f32(e0, e1, r8[j >> 1], false); }
            *(u32x2*)((unsigned char*)T.O + (orow0 + row) * PITCH + h * 128 + ch * 8) = (u32x2){(unsigned)r8[0], (unsigned)r8[1]}; }
        ATT_BAR(0);
    }
#undef ATT_QLOAD
#undef ATT_DMA
}
#undef ATT_PK
}

namespace lru {
typedef short bf16x8 __attribute__((ext_vector_type(8)));
typedef float f32x4l __attribute__((ext_vector_type(4)));
typedef unsigned u32x4 __attribute__((ext_vector_type(4)));
typedef unsigned u32x2 __attribute__((ext_vector_type(2)));
#define LRU_LAS __attribute__((address_space(3)))
constexpr int SEQ = 2048, PITCH = 2048, NT = 32;
constexpr int L_RAW = 0  , L_A = 34816, L_G = 51200  , L_SC = 83968  , RAWB = 17408;
constexpr float LOG2E = 1.4426950408889634f, LN2 = 0.6931471805599453f;
__device__ __forceinline__ unsigned cvtpk(float lo, float hi) { unsigned r; asm volatile("v_cvt_pk_bf16_f32 %0, %1, %2" : "=v"(r) : "v"(lo), "v"(hi)); return r; }
__device__ __forceinline__ float bf_lo(unsigned w) { return __uint_as_float(w << 16); }
__device__ __forceinline__ float bf_hi(unsigned w) { return __uint_as_float(w & 0xffff0000u); }
__device__ __forceinline__ float sigmoidf_fast(float x) { return __builtin_amdgcn_rcpf(1.0f + __builtin_amdgcn_exp2f(-LOG2E * x)); }
struct Params { const unsigned short* U; const unsigned short* G; unsigned short* Y;
    const float* conv_w; const float* conv_b; const float* wa; const float* ba; const float* wx; const float* bx; const float* lam; };

__device__ __forceinline__ void lru_bn(LRU_LAS unsigned char* lds, const Params& P, int b, int n, int wv) {
    int tid_ = wg_tid(wv); asm volatile("" : "+v"(tid_));
    const int tid = tid_, lane = tid & 63, nn = lane & 15, kq = lane >> 4; const int wid = __builtin_amdgcn_readfirstlane(tid >> 6);
    const size_t rowb = (size_t)b * SEQ;
    const unsigned short* Ub = P.U + rowb * PITCH + n * 128; const unsigned short* Gb = P.G + rowb * PITCH + n * 128; unsigned short* Yb = P.Y + rowb * PITCH + n * 128;
    bf16x8 Ba[4], Bx[4];
    { const float* wa0 = P.wa + (size_t)n * 128 * 128 + 16 * wid + nn; const float* wx0 = P.wx + (size_t)n * 128 * 128 + 16 * wid + nn;
#pragma unroll
      for (int ks = 0; ks < 4; ++ks) { u32x4 ta, tx;
#pragma unroll
          for (int j2 = 0; j2 < 4; ++j2) { const int i0 = 32 * ks + 8 * kq + 2 * j2;
              ta[j2] = cvtpk(-LOG2E * wa0[(size_t)i0 * 128], -LOG2E * wa0[(size_t)(i0 + 1) * 128]); tx[j2] = cvtpk(-LOG2E * wx0[(size_t)i0 * 128], -LOG2E * wx0[(size_t)(i0 + 1) * 128]); }
          Ba[ks] = __builtin_bit_cast(bf16x8, ta); Bx[ks] = __builtin_bit_cast(bf16x8, tx); } }
    const int chl = 16 * wid + nn, chg = n * 128 + chl;
    const float c_ba = -LOG2E * P.ba[chg], c_bx = -LOG2E * P.bx[chg];
    const float c_sp = -8.0f * log1pf(expf(-P.lam[chg])) * LOG2E;
    const int tt4 = tid >> 5, cg = tid & 31;
    f32x4l cw0, cw1, cw2, cw3, cbv;
    { const float* cwp = P.conv_w + n * 128 + 4 * cg; cw0 = *(const f32x4l*)(cwp); cw1 = *(const f32x4l*)(cwp + 2048); cw2 = *(const f32x4l*)(cwp + 4096); cw3 = *(const f32x4l*)(cwp + 6144);
      cbv = *(const f32x4l*)(P.conv_b + n * 128 + 4 * cg); }
    LRU_LAS unsigned char* abuf = lds + L_A; LRU_LAS float* sc = (LRU_LAS float*)(lds + L_SC + wid * 2048);
    const __amdgpu_buffer_rsrc_t rU = __builtin_amdgcn_make_buffer_rsrc((void*)Ub, 0, (2047 * PITCH + 128) * 2, 0x00020000), rGt = __builtin_amdgcn_make_buffer_rsrc((void*)Gb, 0, (2047 * PITCH + 128) * 2, 0x00020000);
#define LRU_VOFF() ((lane_id_mb() >> 4) * (PITCH * 2) + (lane_id_mb() & 15) * 16 + wid * (4 * PITCH * 2))
#define LRU_DMA(rs, buf, i, vo, so) __builtin_amdgcn_raw_ptr_buffer_load_lds(rs, (LRU_LAS void*)((buf) + wid * 1024 + (i) * 8192), 16, (int)(vo), (int)(so), 0, 0)
#define LRU_DMA_TILE(t) do { const int vo_ = LRU_VOFF(); LRU_LAS unsigned char* rb_ = lds + L_RAW + ((t) & 1) * RAWB; LRU_LAS unsigned char* gb_ = lds + L_G + ((t) & 1) * 16384; \
        const int su_ = ((t) * 64 - 3) * (PITCH * 2), sg_ = (t) * 64 * (PITCH * 2); \
        LRU_DMA(rU, rb_, 0, vo_, su_); LRU_DMA(rU, rb_, 1, vo_, su_ + 32 * PITCH * 2); if (wid == 0) { if (lane_id_mb() < 48) LRU_DMA(rU, rb_, 2, vo_, su_ + 64 * PITCH * 2); } \
        LRU_DMA(rGt, gb_, 0, vo_, sg_); LRU_DMA(rGt, gb_, 1, vo_, sg_ + 32 * PITCH * 2); } while (0)
#define LRU_BAR(N) do { asm volatile("s_waitcnt vmcnt(" #N ") lgkmcnt(0)" ::: "memory"); __builtin_amdgcn_s_barrier(); asm volatile("" ::: "memory"); } while (0)
    float hc = 0.f;
    { if (tid < 48) *(LRU_LAS u32x4*)(lds + L_RAW + tid * 16) = (u32x4){0u, 0u, 0u, 0u};
      const int vo_ = LRU_VOFF(); LRU_LAS unsigned char* rb_ = lds + L_RAW; LRU_LAS unsigned char* gb_ = lds + L_G;
      if (tid >= 48) LRU_DMA(rU, rb_, 0, vo_ - 3 * PITCH * 2, 0);
      LRU_DMA(rU, rb_, 1, vo_, 29 * PITCH * 2); if (wid == 0) { if (lane_id_mb() < 48) LRU_DMA(rU, rb_, 2, vo_, 61 * PITCH * 2); }
      LRU_DMA(rGt, gb_, 0, vo_, 0); LRU_DMA(rGt, gb_, 1, vo_, 32 * PITCH * 2); }
#define LRU_STORE_Y(tt, gb) do { const u32x4 y0 = *(const LRU_LAS u32x4*)((gb) + tid * 16), y1 = *(const LRU_LAS u32x4*)((gb) + (tid + 512) * 16); \
        *(u32x4*)(Yb + (size_t)((tt) * 64 + (tid >> 4)) * PITCH + (tid & 15) * 8) = y0; *(u32x4*)(Yb + (size_t)((tt) * 64 + 32 + (tid >> 4)) * PITCH + (tid & 15) * 8) = y1; } while (0)
    LRU_BAR(0);
    for (int t = 0; t < NT; ++t) {
        LRU_LAS unsigned char* raw = lds + L_RAW + (t & 1) * RAWB;
        LRU_LAS unsigned char* gbuf = lds + L_G + (t & 1) * 16384; LRU_LAS unsigned char* gnext = lds + L_G + ((t + 1) & 1) * 16384;
        if (t > 0) { LRU_STORE_Y(t - 1, gnext); asm volatile("s_waitcnt lgkmcnt(0)" ::: "memory"); }
        if (t + 1 < NT) LRU_DMA_TILE(t + 1);
        { u32x2 rr[7];
#pragma unroll
          for (int i = 0; i < 7; ++i) rr[i] = *(const LRU_LAS u32x2*)(raw + (4 * tt4 + i) * 256 + cg * 8);
#pragma unroll
          for (int i = 0; i < 4; ++i) { const int tk = 4 * tt4 + i;
              float v0 = cbv[0], v1 = cbv[1], v2 = cbv[2], v3 = cbv[3];
#define LRU_TAP(K, CW) do { const u32x2 x = rr[i + K]; v0 += CW[0] * bf_lo(x.x); v1 += CW[1] * bf_hi(x.x); v2 += CW[2] * bf_lo(x.y); v3 += CW[3] * bf_hi(x.y); } while (0)
              LRU_TAP(0, cw0); LRU_TAP(1, cw1); LRU_TAP(2, cw2); LRU_TAP(3, cw3);
#undef LRU_TAP
              u32x2 w; w.x = cvtpk(v0, v1); w.y = cvtpk(v2, v3);
              *(LRU_LAS u32x2*)(abuf + tk * 256 + (((cg >> 1) ^ (tk & 15)) << 4) + 8 * (cg & 1)) = w; } }
        asm volatile("s_waitcnt lgkmcnt(0)" ::: "memory"); __builtin_amdgcn_s_barrier(); asm volatile("" ::: "memory");
        f32x4l ra[4], rx[4];
#pragma unroll
        for (int blk = 0; blk < 4; ++blk) { const int row = 16 * blk + nn; ra[blk] = (f32x4l){c_ba, c_ba, c_ba, c_ba}; rx[blk] = (f32x4l){c_bx, c_bx, c_bx, c_bx};
#pragma unroll
            for (int ks = 0; ks < 4; ++ks) { const bf16x8 af = *(const LRU_LAS bf16x8*)(abuf + row * 256 + (((4 * ks + kq) ^ (row & 15)) << 4));
                ra[blk] = __builtin_amdgcn_mfma_f32_16x16x32_bf16(af, Ba[ks], ra[blk], 0, 0, 0);
                rx[blk] = __builtin_amdgcn_mfma_f32_16x16x32_bf16(af, Bx[ks], rx[blk], 0, 0, 0); } }
        typedef float f32x2l __attribute__((ext_vector_type(2)));
        float av[4][4], bv[4][4]; f32x4l sA, sB;
#pragma unroll
        for (int blk = 0; blk < 4; ++blk) { float A4 = 1.f, B4 = 0.f;
#pragma unroll
            for (int rp = 0; rp < 4; rp += 2) { const int tok0 = 16 * blk + 4 * kq + rp, tok1 = tok0 + 1;
                const unsigned short ub0 = *(const LRU_LAS unsigned short*)(abuf + tok0 * 256 + (((chl >> 3) ^ (tok0 & 15)) << 4) + (chl & 7) * 2);
                const unsigned short ub1 = *(const LRU_LAS unsigned short*)(abuf + tok1 * 256 + (((chl >> 3) ^ (tok1 & 15)) << 4) + (chl & 7) * 2);
                const f32x2l up = (f32x2l){__uint_as_float((unsigned)ub0 << 16), __uint_as_float((unsigned)ub1 << 16)};
                const f32x2l one = (f32x2l){1.0f, 1.0f};
                const f32x2l da = one + (f32x2l){__builtin_amdgcn_exp2f(ra[blk][rp]), __builtin_amdgcn_exp2f(ra[blk][rp + 1])}, di = one + (f32x2l){__builtin_amdgcn_exp2f(rx[blk][rp]), __builtin_amdgcn_exp2f(rx[blk][rp + 1])};
                const f32x2l pd = da * di; const f32x2l inv = (f32x2l){__builtin_amdgcn_rcpf(pd.x), __builtin_amdgcn_rcpf(pd.y)};
                const f32x2l r = di * inv, ig = da * inv;
                const f32x2l l2a = r * c_sp; const f32x2l a = (f32x2l){__builtin_amdgcn_exp2f(l2a.x), __builtin_amdgcn_exp2f(l2a.y)};
                const f32x2l oma = one - a, em = oma * ((f32x2l){2.0f, 2.0f} - oma);
                const f32x2l bb = (f32x2l){__builtin_amdgcn_sqrtf(em.x), __builtin_amdgcn_sqrtf(em.y)} * ig * up;
                av[blk][rp] = a.x; bv[blk][rp] = bb.x; av[blk][rp + 1] = a.y; bv[blk][rp + 1] = bb.y;
                A4 *= a.x; B4 = B4 * a.x + bb.x; A4 *= a.y; B4 = B4 * a.y + bb.y; }
            sA[blk] = A4; sB[blk] = B4; }
        *(LRU_LAS f32x4l*)(sc + (nn * 4 + kq) * 4) = sA; *(LRU_LAS f32x4l*)(sc + 256 + (nn * 4 + kq) * 4) = sB;
        __builtin_amdgcn_fence(__ATOMIC_RELEASE, "wavefront"); asm volatile("s_waitcnt lgkmcnt(0)" ::: "memory");
        f32x4l gA[4], gB[4];
#pragma unroll
        for (int q = 0; q < 4; ++q) { gA[q] = *(const LRU_LAS f32x4l*)(sc + nn * 16 + q * 4); gB[q] = *(const LRU_LAS f32x4l*)(sc + 256 + nn * 16 + q * 4); }
        float hin[4]; float h = hc;
#pragma unroll
        for (int s = 0; s < 16; ++s) { const int blk = s >> 2, q = s & 3; if (q == kq) hin[blk] = h; h = gA[q][blk] * h + gB[q][blk]; }
        hc = h;
        asm volatile("" ::: "memory");
#pragma unroll
        for (int blk = 0; blk < 4; ++blk) { float hh = hin[blk];
#pragma unroll
            for (int rg = 0; rg < 4; ++rg) { const int tok = 16 * blk + 4 * kq + rg;
                hh = av[blk][rg] * hh + bv[blk][rg];
                LRU_LAS unsigned short* gp = (LRU_LAS unsigned short*)(gbuf + tok * 256 + chl * 2);
                const float sg = __uint_as_float((unsigned)(*gp) << 16);
                *gp = (unsigned short)(cvtpk(hh * sg, 0.f) & 0xffffu); } }
        LRU_BAR(0);
    }
    LRU_STORE_Y(NT - 1, lds + L_G + ((NT - 1) & 1) * 16384);
#undef LRU_STORE_Y
#undef LRU_DMA_TILE
#undef LRU_DMA
#undef LRU_VOFF
    __syncthreads();
}
}

#define GAS __attribute__((address_space(1)))
#define LAS __attribute__((address_space(3)))
typedef unsigned short bf16;
typedef unsigned v4u __attribute__((ext_vector_type(4)));
typedef unsigned v2u __attribute__((ext_vector_type(2)));
typedef float f32x4 __attribute__((ext_vector_type(4)));
typedef short bf16x8 __attribute__((ext_vector_type(8)));
typedef GAS unsigned gu32;
typedef GAS unsigned long long gu64;
#define RLX_AGENT __ATOMIC_RELAXED, __HIP_MEMORY_SCOPE_AGENT
#define LDS_WAIT() asm volatile("s_waitcnt lgkmcnt(0)" ::: "memory")
#define VM_WAIT() asm volatile("s_waitcnt vmcnt(0)" ::: "memory")
__device__ __forceinline__ unsigned long long rt() { return __builtin_amdgcn_s_memrealtime(); }
__device__ __forceinline__ unsigned f2bf(float f) { unsigned u = __builtin_bit_cast(unsigned, f); return (u + 0x7fffu + ((u >> 16) & 1u)) >> 16; }
__device__ __forceinline__ unsigned pk2(float lo, float hi) { return f2bf(lo) | (f2bf(hi) << 16); }

#define XB_TMO      128
#define XB_XCNT(j)  (256  + 64 * (j))
#define XB_XSUB(j)  (1280 + 64 * (j))
#define XB_XGEN(j)  (2304 + 64 * (j))
#define XB_TOP      3328
#define XB_TOPGEN   3392
#define XCD_BAR_WORDS 3456
#define XB_SPIN_CAP (1u << 18)

__device__ __forceinline__ unsigned xb_ld(unsigned* p)              { return __hip_atomic_load(p, __ATOMIC_RELAXED, __HIP_MEMORY_SCOPE_AGENT); }
__device__ __forceinline__ unsigned xb_add(unsigned* p, unsigned v) { return __hip_atomic_fetch_add(p, v, __ATOMIC_RELAXED, __HIP_MEMORY_SCOPE_AGENT); }
__device__ __forceinline__ unsigned xb_xcc_id() { return (unsigned)__builtin_amdgcn_s_getreg((3 << 11) | 20) & 0xFu; }
#define XB_SPIN(cond, bar) do { unsigned _sp = 0; while (cond) { __builtin_amdgcn_s_sleep(1); \
    if ((++_sp & 255u) == 0u) { if (xb_ld(&(bar)[XB_TMO])) break; if (_sp > XB_SPIN_CAP) { atomicAdd(&(bar)[XB_TMO], 1u); break; } } } } while (0)

struct XcdBarrier {
    unsigned* bar; unsigned x;
    volatile LAS unsigned* st;
    unsigned G;
};

__device__ __forceinline__ XcdBarrier xcd_barrier_post(unsigned* bar, volatile LAS unsigned* st, bool leader, unsigned G) {
    XcdBarrier b; b.bar = bar; b.x = xb_xcc_id(); b.st = st; b.G = G;
    if (leader) (void)xb_add(&bar[XB_XCNT(b.x)], 1u);
    return b;
}
__device__ __forceinline__ void xcd_barrier_complete(unsigned* bar, unsigned x, unsigned G, unsigned& nloc, unsigned& nx) {
    unsigned sum, cnt, mine, sp = 0u;
    for (;;) {
        sum = 0u; cnt = 0u; mine = 0u;
#pragma unroll
        for (unsigned j = 0; j < 16; ++j) { const unsigned c = xb_ld(&bar[XB_XCNT(j)]); sum += c; cnt += (c > 0u) ? 1u : 0u; mine = (j == x) ? c : mine; }
        if (sum == G) break;
        __builtin_amdgcn_s_sleep(1);
        if ((++sp & 255u) == 0u) { if (xb_ld(&bar[XB_TMO])) break; if (sp > XB_SPIN_CAP) { atomicAdd(&bar[XB_TMO], 1u); break; } }
    }
    nloc = mine > 0u ? mine : 1u; nx = cnt > 0u ? cnt : 1u;
}

__device__ __forceinline__ void xcd_barrier(const XcdBarrier& b, bool leader) {
    asm volatile("s_waitcnt vmcnt(0)" ::: "memory");
    __syncthreads();
    if (leader) {
        unsigned* bar = b.bar;
        __builtin_amdgcn_s_waitcnt(0);
        unsigned nloc = b.st[0], nx = b.st[1];
        if (nloc == 0u) { xcd_barrier_complete(bar, b.x, b.G, nloc, nx); b.st[0] = nloc; b.st[1] = nx; }
        const unsigned old = xb_add(&bar[XB_XSUB(b.x)], 1u);
        const unsigned gen = old / nloc;
        if (old + 1u == (gen + 1u) * nloc) {
            if (nx > 1u) {
            __builtin_amdgcn_fence(__ATOMIC_RELEASE, "agent");
            asm volatile("s_waitcnt vmcnt(0)" ::: "memory");
            const unsigned og = xb_add(&bar[XB_TOP], 1u);
            const unsigned tg = og / nx;
            if (og + 1u == (tg + 1u) * nx) xb_add(&bar[XB_TOPGEN], 1u);
            else XB_SPIN(xb_ld(&bar[XB_TOPGEN]) == tg, bar); }
            __builtin_amdgcn_fence(__ATOMIC_ACQUIRE, "agent");
            xb_add(&bar[XB_XGEN(b.x)], 1u);
            asm volatile("s_waitcnt vmcnt(0)" ::: "memory");
        } else {
            XB_SPIN(xb_ld(&bar[XB_XGEN(b.x)]) == gen, bar);
            __builtin_amdgcn_fence(__ATOMIC_ACQUIRE, "agent");
            asm volatile("s_waitcnt vmcnt(0)" ::: "memory");
        }
    }
    __syncthreads();
}

constexpr int NWAVES = 8;
constexpr int BATCH = 16, SEQ = 2048, DM = 2048, NH = 16, HD = 128;
constexpr int M = BATCH * SEQ;
constexpr int MH = M / 8;
constexpr int N1 = 4 * DM, N3 = 2 * DM;
constexpr float LN_EPS = 1e-5f;
constexpr float DN_ALPHA = 1.4142135623730951f;
constexpr float QSCALE = 0.08838834764831845f * 1.4426950408889634f;

constexpr size_t MiB = 1u << 20;
constexpr size_t WS_CTL = 0, CTL_ZERO_BYTES = 256 * 1024;
constexpr size_t WS_W1T = 2 * MiB, WS_W2T = 34 * MiB, WS_W3T = 42 * MiB, WS_W4T = 58 * MiB;
constexpr size_t WS_R0 = 80 * MiB, WS_R1 = 208 * MiB, WS_R2 = 336 * MiB, WS_R3 = 464 * MiB, WS_R4 = 592 * MiB, WS_HC = 720 * MiB, WS_END = 752 * MiB;
constexpr int CW_TMO = 0, CW_CODE = 1, CW_BAR = 4096;
constexpr int CW_BAR_STRIDE = 4096, NGRP = 8;
static_assert((CW_BAR + (1 + NGRP) * CW_BAR_STRIDE) * 4 <= (int)CTL_ZERO_BYTES && XCD_BAR_WORDS <= CW_BAR_STRIDE, "barrier words inside the memset region");

constexpr int RING_OFF = 0, RING_BYTES = 131072;
constexpr int LDSCTL_OFF = RING_BYTES, MISC_OFF = LDSCTL_OFF + 320, TL_OFF = LDSCTL_OFF + 1024;
constexpr int LDS_BYTES = 147456;
static_assert(TL_OFF + 640 * 4 <= LDS_BYTES, "LDS map");

struct Frame {
    LAS unsigned char* lds; volatile LAS unsigned* MISC; gu32* ctl;
    int tid, lane, wave, vcu, G;
};
__device__ __forceinline__ unsigned cvt_pk(float lo, float hi) { unsigned r; asm volatile("v_cvt_pk_bf16_f32 %0, %1, %2" : "=v"(r) : "v"(lo), "v"(hi)); return r; }
__device__ __forceinline__ float wave_sum(float v) {
#pragma unroll
    for (int o = 1; o < 64; o <<= 1) v += __shfl_xor(v, o);
    return v;
}
__device__ __forceinline__ unsigned h1_corr(float h, unsigned hb_bits) {
    const unsigned e8 = (hb_bits >> 23) & 0xffu; const float inv = __uint_as_float((265u - e8) << 23);
    int q = (int)__builtin_rintf((h - __uint_as_float(hb_bits)) * inv); q = e8 < 11u ? 0 : (q > 7 ? 7 : q);
    return (unsigned)q & 0xfu; }
__device__ __forceinline__ float h1_rebuild(unsigned hb_bits, unsigned cword, int sh) {
    const unsigned e8 = (hb_bits >> 23) & 0xffu; const float step = __uint_as_float(e8 < 12u ? 0u : (e8 - 11u) << 23);
    const int q = ((int)(cword << (28 - sh))) >> 28;
    return __uint_as_float(hb_bits) + (float)q * step; }
struct P0Mat { const float* W; bf16* WT; int N; int q8; int first; };
__device__ __forceinline__ void p0_item_load(const P0Mat& m, int item, int lane, f32x4 (&r)[8]) {
    const int nblk = m.N / 32, it = item - m.first, kb = it / nblk, nb = it % nblk;
    const float* p = m.W + (size_t)(64 * kb + (lane >> 3)) * m.N + 32 * nb + 4 * (lane & 7);
#pragma unroll
    for (int i = 0; i < 8; ++i) r[i] = *(const f32x4*)(p + (size_t)(8 * i) * m.N);
}
__device__ __forceinline__ void p0_item_store(const P0Mat& m, int item, int lane, const f32x4 (&r)[8], LAS float* scr) {
    const int K = DM, nblk = m.N / 32, it = item - m.first, kb = it / nblk, nb = it % nblk, k0 = 64 * kb, n0 = 32 * nb;
#pragma unroll
    for (int i = 0; i < 8; ++i) { LAS float* d = scr + (8 * i + (lane >> 3)) * 33 + 4 * (lane & 7); d[0] = r[i].x; d[1] = r[i].y; d[2] = r[i].z; d[3] = r[i].w; }
    LDS_WAIT(); asm volatile("" ::: "memory");
    const int c = lane & 7;
#pragma unroll
    for (int j = 0; j < 4; ++j) { const int n = (lane >> 3) + 8 * j; const LAS float* s = scr + (8 * c) * 33 + n;
        float v[8];
#pragma unroll
        for (int i = 0; i < 8; ++i) v[i] = s[i * 33];
        if (m.q8) { int w0 = 0, w1 = 0;
            w0 = __builtin_amdgcn_cvt_pk_fp8_f32(v[0] * 64.f, v[1] * 64.f, w0, false); w0 = __builtin_amdgcn_cvt_pk_fp8_f32(v[2] * 64.f, v[3] * 64.f, w0, true);
            w1 = __builtin_amdgcn_cvt_pk_fp8_f32(v[4] * 64.f, v[5] * 64.f, w1, false); w1 = __builtin_amdgcn_cvt_pk_fp8_f32(v[6] * 64.f, v[7] * 64.f, w1, true);
            *(GAS v2u*)((GAS unsigned char*)m.WT + (size_t)(n0 + n) * K + k0 + 8 * c) = (v2u){(unsigned)w0, (unsigned)w1};
        } else { v4u o; o.x = cvt_pk(v[0], v[1]); o.y = cvt_pk(v[2], v[3]); o.z = cvt_pk(v[4], v[5]); o.w = cvt_pk(v[6], v[7]);
            *(GAS v4u*)(m.WT + (size_t)(n0 + n) * K + k0 + 8 * c) = o; } }
    LDS_WAIT(); asm volatile("" ::: "memory");
}

struct Args { const float* in[15]; float* out; unsigned char* ws; int ph_lo, ph_hi; };
__global__ void __launch_bounds__(NWAVES * 64, 2) hybrid_fwd(Args args) {
    extern __shared__ __attribute__((aligned(16))) unsigned char lds[];
    Frame F;
    F.lds = (LAS unsigned char*)lds;
    F.MISC = (volatile LAS unsigned*)(F.lds + MISC_OFF);
    F.wave = __builtin_amdgcn_readfirstlane((int)threadIdx.x >> 6);
    const int bx = blockIdx.x, GT = gridDim.x, GH = GT / NGRP, grp = bx & 7, lb = bx >> 3;
    F.G = GH; F.vcu = lb;
    const int rowbase = grp * MH;
    unsigned char* ws = args.ws;
    F.ctl = (gu32*)(ws + WS_CTL);
    const float* x = args.in[0]; const float* attn_w_in = args.in[1]; const float* attn_w_out = args.in[2]; const float* rel_bias = args.in[3];
    const float* lru_w_in = args.in[4]; const float* conv_w = args.in[5]; const float* conv_b = args.in[6]; const float* lru_wa = args.in[7]; const float* lru_ba = args.in[8];
    const float* lru_wx = args.in[9]; const float* lru_bx = args.in[10]; const float* lru_lam = args.in[11]; const float* lru_w_out = args.in[12];
    const float* ln_gain = args.in[13]; const float* ln_bias = args.in[14];
    float* out = args.out;
    bf16* W1t = (bf16*)(ws + WS_W1T); bf16* W2t = (bf16*)(ws + WS_W2T); bf16* W3t = (bf16*)(ws + WS_W3T); bf16* W4t = (bf16*)(ws + WS_W4T);
    unsigned char* HC = ws + WS_HC;
    bf16* R0 = (bf16*)(ws + WS_R0); bf16* R1 = (bf16*)(ws + WS_R1); bf16* R2 = (bf16*)(ws + WS_R2); bf16* R3 = (bf16*)(ws + WS_R3); bf16* R4 = (bf16*)(ws + WS_R4);

    for (int u = (F.wave * 64 + lane_id_mb()); u < (LDS_BYTES - LDSCTL_OFF) / 4; u += NWAVES * 64) ((LAS unsigned*)(F.lds + LDSCTL_OFF))[u] = 0u;
    __syncthreads();
    XcdBarrier bar_all = xcd_barrier_post((unsigned*)(F.ctl + CW_BAR), F.MISC + 8, F.wave == 0 && lane_id_mb() == 0, (unsigned)GT);
    XcdBarrier bar = xcd_barrier_post((unsigned*)(F.ctl + CW_BAR + CW_BAR_STRIDE * (1 + grp)), F.MISC + 10, F.wave == 0 && lane_id_mb() == 0, (unsigned)GH);
    const int lo = args.ph_lo, hi = args.ph_hi;
#define IN(k) (lo <= (k) && (k) < hi)
#define GRID_BAR() xcd_barrier(bar, F.wave == 0 && lane_id_mb() == 0)
    const int gw = F.vcu * NWAVES + F.wave, NGW = GH * NWAVES;

    if (IN(0)) {
        constexpr int I1 = (DM / 64) * (N1 / 32), I2 = (DM / 64) * (DM / 32), I3 = (DM / 64) * (N3 / 32), I4 = I2, NITEMS = I1 + I2 + I3 + I4;
        const P0Mat m1{attn_w_in, W1t, N1, 1, 0}, m2{attn_w_out, W2t, DM, 1, I1}, m3{lru_w_in, W3t, N3, 0, I1 + I2}, m4{lru_w_out, W4t, DM, 0, I1 + I2 + I3};
#define P0_MAT(it) ((it) < I1 ? m1 : (it) < I1 + I2 ? m2 : (it) < I1 + I2 + I3 ? m3 : m4)
        { const int ln = lane_id_mb(); LAS unsigned char* wbuf = F.lds + RING_OFF + F.wave * 16384;
          const int it0 = ((bx % 8) * (GT / 8) + bx / 8) * NWAVES + F.wave, ist = GT * NWAVES;
#define W_DMA(it_, b_) do { const P0Mat mm_ = P0_MAT(it_); const int nblk_ = mm_.N / 32, itl_ = (it_) - mm_.first, kb_ = itl_ / nblk_, nb_ = itl_ % nblk_; \
              const __amdgpu_buffer_rsrc_t rw_ = __builtin_amdgcn_make_buffer_rsrc((void*)mm_.W, 0, (int)((unsigned)mm_.N * DM * 4u), 0x00020000); \
              const unsigned so_ = ((unsigned)(64 * kb_) * mm_.N + 32u * nb_) * 4u; const int l_ = lane_id_mb(); \
              _Pragma("unroll") for (int i = 0; i < 8; ++i) __builtin_amdgcn_raw_ptr_buffer_load_lds(rw_, (LAS void*)(wbuf + (b_) * 8192 + i * 1024), 16, \
                  (int)(((unsigned)(8 * i + (l_ >> 3)) * mm_.N) * 4u + ((unsigned)((l_ & 7) ^ i) << 4)), (int)so_, 0, 0); } while (0)
          if (it0 < NITEMS) W_DMA(it0, 0);
          if (it0 + ist < NITEMS) W_DMA(it0 + ist, 1);
          v4u ob[4]; int itp = -1, k = 0;
#pragma unroll
          for (int j = 0; j < 4; ++j) ob[j] = (v4u){0u, 0u, 0u, 0u};
#define W_STORE() do { const P0Mat mp_ = P0_MAT(itp); const int nblk_ = mp_.N / 32, itl_ = itp - mp_.first, k0_ = 64 * (itl_ / nblk_), n0_ = 32 * (itl_ % nblk_), c_ = ln & 7; \
              _Pragma("unroll") for (int j = 0; j < 4; ++j) { const int n_ = (ln >> 3) + 8 * j; \
                  if (mp_.q8) *(GAS v2u*)((GAS unsigned char*)mp_.WT + (size_t)(n0_ + n_) * DM + k0_ + 8 * c_) = (v2u){ob[j].x, ob[j].y}; \
                  else *(GAS v4u*)(mp_.WT + (size_t)(n0_ + n_) * DM + k0_ + 8 * c_) = ob[j]; } } while (0)
          for (int it = it0; it < NITEMS; it += ist, k ^= 1) {
              if (it + ist < NITEMS) asm volatile("s_waitcnt vmcnt(8)" ::: "memory"); else asm volatile("s_waitcnt vmcnt(0)" ::: "memory");
              float v[4][8];
              { const int c = ln & 7;
#pragma unroll
                for (int j = 0; j < 4; ++j) { const int n = (ln >> 3) + 8 * j; const LAS unsigned char* sp = wbuf + k * 8192 + (8 * c) * 128 + (((n >> 2) ^ c) << 4) + (n & 3) * 4;
#pragma unroll
                    for (int i = 0; i < 8; ++i) v[j][i] = *(const LAS float*)(sp + i * 128); } }
              asm volatile("s_waitcnt lgkmcnt(0)" ::: "memory");
              if (itp >= 0) W_STORE();
              if (it + 2 * ist < NITEMS) W_DMA(it + 2 * ist, k);
              const bool q8 = P0_MAT(it).q8 != 0;
#pragma unroll
              for (int j = 0; j < 4; ++j) {
                  if (q8) { int w0 = 0, w1 = 0;
                      w0 = __builtin_amdgcn_cvt_pk_fp8_f32(v[j][0] * 64.f, v[j][1] * 64.f, w0, false); w0 = __builtin_amdgcn_cvt_pk_fp8_f32(v[j][2] * 64.f, v[j][3] * 64.f, w0, true);
                      w1 = __builtin_amdgcn_cvt_pk_fp8_f32(v[j][4] * 64.f, v[j][5] * 64.f, w1, false); w1 = __builtin_amdgcn_cvt_pk_fp8_f32(v[j][6] * 64.f, v[j][7] * 64.f, w1, true);
                      ob[j] = (v4u){(unsigned)w0, (unsigned)w1, 0u, 0u};
                  } else ob[j] = (v4u){cvt_pk(v[j][0], v[j][1]), cvt_pk(v[j][2], v[j][3]), cvt_pk(v[j][4], v[j][5]), cvt_pk(v[j][6], v[j][7])}; }
              itp = it; }
          if (itp >= 0) W_STORE();
#undef W_STORE
#undef W_DMA
        }
#undef P0_MAT
        { LAS unsigned char* rbuf = F.lds + RING_OFF + F.wave * 16384; const int ln = lane_id_mb();
          const __amdgpu_buffer_rsrc_t rX = __builtin_amdgcn_make_buffer_rsrc((void*)x, 0, (int)((unsigned)M * DM * 4u), 0x00020000);
#define XROW_DMA(r_, b_) do { const unsigned sx_ = (unsigned)(r_) * (DM * 4u); const int vo_ = lane_id_mb() * 16; \
              _Pragma("unroll") for (int j = 0; j < 8; ++j) __builtin_amdgcn_raw_ptr_buffer_load_lds(rX, (LAS void*)(rbuf + (b_) * 8192 + j * 1024), 16, vo_, (int)(sx_ + j * 1024u), 0, 0); } while (0)
          const int r0 = rowbase + gw, rend = rowbase + MH;
          if (r0 < rend) XROW_DMA(r0, 0);
          if (r0 + NGW < rend) XROW_DMA(r0 + NGW, 1);
          v4u qp0 = (v4u){0u, 0u, 0u, 0u}, qp1 = qp0; int rp = -1, k = 0;
          for (int r = r0; r < rend; r += NGW, k ^= 1) {
              if (r + NGW < rend) asm volatile("s_waitcnt vmcnt(8)" ::: "memory"); else asm volatile("s_waitcnt vmcnt(0)" ::: "memory");
              f32x4 v[2][4];
#pragma unroll
              for (int jj = 0; jj < 2; ++jj)
#pragma unroll
                  for (int e = 0; e < 4; ++e) v[jj][e] = *(const LAS f32x4*)(rbuf + k * 8192 + (1024 * jj + 16 * ln + 4 * e) * 4);
              asm volatile("s_waitcnt lgkmcnt(0)" ::: "memory");
              if (rp >= 0) { GAS v4u* xq = (GAS v4u*)((GAS unsigned char*)R0 + (size_t)rp * DM); xq[ln] = qp0; xq[64 + ln] = qp1; }
              if (r + 2 * NGW < rend) XROW_DMA(r + 2 * NGW, k);
#pragma unroll
              for (int jj = 0; jj < 2; ++jj) { int w[4] = {0, 0, 0, 0};
#pragma unroll
                  for (int e = 0; e < 4; ++e) { w[e] = __builtin_amdgcn_cvt_pk_fp8_f32(v[jj][e].x, v[jj][e].y, w[e], false); w[e] = __builtin_amdgcn_cvt_pk_fp8_f32(v[jj][e].z, v[jj][e].w, w[e], true); }
                  if (jj == 0) qp0 = (v4u){(unsigned)w[0], (unsigned)w[1], (unsigned)w[2], (unsigned)w[3]}; else qp1 = (v4u){(unsigned)w[0], (unsigned)w[1], (unsigned)w[2], (unsigned)w[3]}; }
              rp = r; }
          if (rp >= 0) { GAS v4u* xq = (GAS v4u*)((GAS unsigned char*)R0 + (size_t)rp * DM); xq[ln] = qp0; xq[64 + ln] = qp1; }
#undef XROW_DMA
        }
        xcd_barrier(bar_all, F.wave == 0 && lane_id_mb() == 0);
    }
    if (IN(1)) {
        pg8::Gemm g{R0 + (size_t)rowbase * (DM / 2), W1t, MH, N1, DM / 2, 0x7f7f7f7f, 0x79797979}; pg8::StaticOrder S; S.init(MH, N1, GH, lb);
        pg8::EpiBf16<0> E{R1, DM, nullptr, DM, (size_t)(WS_R2 - WS_R1) / 2, QSCALE, -1, 3, rowbase};
        pg8::gemm_phase<pg8::EpiBf16<0>, pg8::StaticOrder, true, true, true>(F.lds + RING_OFF, g, S, E, F.wave);
        GRID_BAR();
    }
    if (IN(2)) {
        const att::Tensors T{R1, R2, R3, R4, R0, rel_bias};
        for (int bh = grp * (BATCH * NH / NGRP) + F.vcu; bh < (grp + 1) * (BATCH * NH / NGRP); bh += GH) att::attn_bh(F.lds + RING_OFF, (LAS float*)(F.lds + TL_OFF), T, bh / NH, bh % NH, F.wave);
        GRID_BAR();
    }
    if (IN(3)) {
        pg8::Gemm g{R0 + (size_t)rowbase * (DM / 2), W2t, MH, DM, DM / 2, 0x79797979, 0x79797979}; pg8::StaticOrder S; S.init(MH, DM, GH, lb);
        pg8::EpiBf16<0> E{R1, DM, nullptr, 0, 0, 1.0f, -1, 0, rowbase};
        pg8::gemm_phase<pg8::EpiBf16<0>, pg8::StaticOrder, true, true, true>(F.lds + RING_OFF, g, S, E, F.wave);
        GRID_BAR();
    }
    if (IN(4)) {
        const int ln = lane_id_mb();
        f32x4 gv[8], bv[8];
#pragma unroll
        for (int j = 0; j < 8; ++j) { gv[j] = *(const f32x4*)(ln_gain + 4 * ln + 256 * j); bv[j] = *(const f32x4*)(ln_bias + 4 * ln + 256 * j); }
        LAS unsigned char* rbuf = F.lds + RING_OFF + F.wave * 16384;
        const __amdgpu_buffer_rsrc_t rX = __builtin_amdgcn_make_buffer_rsrc((void*)x, 0, (int)((unsigned)M * DM * 4u), 0x00020000), rY = __builtin_amdgcn_make_buffer_rsrc((void*)R1, 0, (int)((unsigned)M * DM * 2u), 0x00020000);
#define ROW_DMA2(r_) do { const unsigned sx_ = (unsigned)(r_) * (DM * 4u), sy_ = (unsigned)(r_) * (DM * 2u); const int vo_ = lane_id_mb() * 16; \
            _Pragma("unroll") for (int j = 0; j < 8; ++j) __builtin_amdgcn_raw_ptr_buffer_load_lds(rX, (LAS void*)(rbuf + j * 1024), 16, vo_, (int)(sx_ + j * 1024u), 0, 0); \
            _Pragma("unroll") for (int j = 0; j < 4; ++j) __builtin_amdgcn_raw_ptr_buffer_load_lds(rY, (LAS void*)(rbuf + 8192 + j * 1024), 16, vo_, (int)(sy_ + j * 1024u), 0, 0); } while (0)
        const int rend = rowbase + MH;
        if (rowbase + gw < rend) ROW_DMA2(rowbase + gw);
        v2u hp[8]; v4u cp; int rp = -1;
#pragma unroll
        for (int j = 0; j < 8; ++j) hp[j] = (v2u){0u, 0u};
        cp = (v4u){0u, 0u, 0u, 0u};
#define ROW_STORE2() do { GAS v2u* o4 = (GAS v2u*)(R2 + (size_t)rp * DM) + ln; _Pragma("unroll") for (int j = 0; j < 8; ++j) o4[64 * j] = hp[j]; ((GAS v4u*)(HC + (size_t)rp * (DM / 2)))[ln] = cp; } while (0)
        for (int r = rowbase + gw; r < rend; r += NGW) {
            asm volatile("s_waitcnt vmcnt(0)" ::: "memory");
            f32x4 z[8]; float s = 0.f;
            { f32x4 xv[8]; v2u yv[8];
#pragma unroll
              for (int j = 0; j < 8; ++j) { xv[j] = *(const LAS f32x4*)(rbuf + (256 * j + 4 * ln) * 4); yv[j] = *(const LAS v2u*)(rbuf + 8192 + (256 * j + 4 * ln) * 2); }
              asm volatile("s_waitcnt lgkmcnt(0)" ::: "memory");
              if (r + NGW < rend) ROW_DMA2(r + NGW);
              if (rp >= 0) ROW_STORE2();
#pragma unroll
              for (int j = 0; j < 8; ++j) {
                  z[j] = xv[j] * DN_ALPHA + (f32x4){__uint_as_float(yv[j].x << 16), __uint_as_float(yv[j].x & 0xffff0000u), __uint_as_float(yv[j].y << 16), __uint_as_float(yv[j].y & 0xffff0000u)};
                  s += (z[j].x + z[j].y) + (z[j].z + z[j].w); } }
            const float mean = wave_sum(s) * (1.0f / DM); float q = 0.f;
#pragma unroll
            for (int j = 0; j < 8; ++j) { z[j] = z[j] - mean; q += (z[j].x * z[j].x + z[j].y * z[j].y) + (z[j].z * z[j].z + z[j].w * z[j].w); }
            const float rstd = 1.0f / sqrtf(wave_sum(q) * (1.0f / DM) + LN_EPS);
            unsigned cw[4] = {0u, 0u, 0u, 0u};
#pragma unroll
            for (int j = 0; j < 8; ++j) { const f32x4 h = (z[j] * rstd) * gv[j] + bv[j]; const v2u p = (v2u){cvt_pk(h.x, h.y), cvt_pk(h.z, h.w)}; hp[j] = p;
                const unsigned hb[4] = {p.x << 16, p.x & 0xffff0000u, p.y << 16, p.y & 0xffff0000u};
#pragma unroll
                for (int e = 0; e < 4; ++e) { cw[j >> 1] |= h1_corr(h[e], hb[e]) << (16 * (j & 1) + 4 * e); } }
            cp = (v4u){cw[0], cw[1], cw[2], cw[3]}; rp = r;
        }
        if (rp >= 0) ROW_STORE2();
#undef ROW_STORE2
#undef ROW_DMA2
        GRID_BAR();
    }
    if (IN(5)) {
        pg8::Gemm g{R2 + (size_t)rowbase * DM, W3t, MH, N3, DM, 0, 0}; pg8::StaticOrder S; S.init(MH, N3, GH, lb);
        pg8::EpiBf16<0> E{R0, DM, nullptr, DM, (size_t)(WS_R4 - WS_R0) / 2, 1.0f, 1, 0, rowbase};
        pg8::gemm_phase<pg8::EpiBf16<0>, pg8::StaticOrder, true, true>(F.lds + RING_OFF, g, S, E, F.wave);
        GRID_BAR();
    }
    if (IN(6)) {
        const lru::Params P{R0, R4, R3, conv_w, conv_b, lru_wa, lru_ba, lru_wx, lru_bx, lru_lam};
        for (int bn = grp * (BATCH * 16 / NGRP) + F.vcu; bn < (grp + 1) * (BATCH * 16 / NGRP); bn += GH) lru::lru_bn(F.lds + RING_OFF, P, bn / 16, bn % 16, F.wave);
        GRID_BAR();
    }
    if (IN(7)) {
        pg8::Gemm g{R3 + (size_t)rowbase * DM, W4t, MH, DM, DM, 0, 0}; pg8::StaticOrder S; S.init(MH, DM, GH, lb);
        pg8::EpiBf16<0> E{R1, DM, nullptr, 0, 0, 1.0f, -1, 0, rowbase};
        pg8::gemm_phase<pg8::EpiBf16<0>, pg8::StaticOrder, true, true>(F.lds + RING_OFF, g, S, E, F.wave);
        GRID_BAR();
    }
    if (IN(8)) {
        unsigned bad = __hip_atomic_load(F.ctl + CW_BAR + XB_TMO, RLX_AGENT);
#pragma unroll
        for (int gi = 1; gi <= NGRP; ++gi) bad |= __hip_atomic_load(F.ctl + CW_BAR + gi * CW_BAR_STRIDE + XB_TMO, RLX_AGENT);
        const int ln = lane_id_mb();
        f32x4 g1v[8], b1v[8];
#pragma unroll
        for (int j = 0; j < 8; ++j) { g1v[j] = *(const f32x4*)(ln_gain + DM + 4 * ln + 256 * j); b1v[j] = *(const f32x4*)(ln_bias + DM + 4 * ln + 256 * j); }
        LAS unsigned char* rbuf = F.lds + RING_OFF + F.wave * 16384;
        const __amdgpu_buffer_rsrc_t rH = __builtin_amdgcn_make_buffer_rsrc((void*)R2, 0, (int)((unsigned)M * DM * 2u), 0x00020000), rW = __builtin_amdgcn_make_buffer_rsrc((void*)R1, 0, (int)((unsigned)M * DM * 2u), 0x00020000),
                                     rC = __builtin_amdgcn_make_buffer_rsrc((void*)HC, 0, (int)((unsigned)M * (DM / 2)), 0x00020000);
#define ROW_DMA3(r_) do { const unsigned sh_ = (unsigned)(r_) * (DM * 2u), sc_ = (unsigned)(r_) * (DM / 2); const int vo_ = lane_id_mb() * 16; \
            _Pragma("unroll") for (int j = 0; j < 4; ++j) __builtin_amdgcn_raw_ptr_buffer_load_lds(rH, (LAS void*)(rbuf + j * 1024), 16, vo_, (int)(sh_ + j * 1024u), 0, 0); \
            _Pragma("unroll") for (int j = 0; j < 4; ++j) __builtin_amdgcn_raw_ptr_buffer_load_lds(rW, (LAS void*)(rbuf + 4096 + j * 1024), 16, vo_, (int)(sh_ + j * 1024u), 0, 0); \
            __builtin_amdgcn_raw_ptr_buffer_load_lds(rC, (LAS void*)(rbuf + 8192), 16, vo_, (int)sc_, 0, 0); } while (0)
        const __amdgpu_buffer_rsrc_t rOut = __builtin_amdgcn_make_buffer_rsrc((void*)out, 0, (int)((unsigned)M * DM * 4u), 0x00020000);
        const int rend = rowbase + MH;
        if (rowbase + gw < rend) ROW_DMA3(rowbase + gw);
        f32x4 op[8]; int rp = -1;
#pragma unroll
        for (int j = 0; j < 8; ++j) op[j] = (f32x4){0.f, 0.f, 0.f, 0.f};
#define ROW_STORE3() do { _Pragma("unroll") for (int j = 0; j < 8; ++j) __builtin_amdgcn_raw_buffer_store_b128(__builtin_bit_cast(v4u, op[j]), rOut, ln * 16 + j * 1024, (int)((unsigned)rp * (DM * 4u)), 16  ); } while (0)
        for (int r = rowbase + gw; r < rend; r += NGW) {
            asm volatile("s_waitcnt vmcnt(0)" ::: "memory");
            f32x4 z[8]; float s = 0.f;
            { v2u hv[8], wv[8]; const v4u cn = *(const LAS v4u*)(rbuf + 8192 + ln * 16);
#pragma unroll
              for (int j = 0; j < 8; ++j) { hv[j] = *(const LAS v2u*)(rbuf + (256 * j + 4 * ln) * 2); wv[j] = *(const LAS v2u*)(rbuf + 4096 + (256 * j + 4 * ln) * 2); }
              asm volatile("s_waitcnt lgkmcnt(0)" ::: "memory");
              if (r + NGW < rend) ROW_DMA3(r + NGW);
              if (rp >= 0) ROW_STORE3();
#pragma unroll
              for (int j = 0; j < 8; ++j) { const unsigned cwd = cn[j >> 1]; const int sh = 16 * (j & 1);
                  const f32x4 h = (f32x4){h1_rebuild(hv[j].x << 16, cwd, sh), h1_rebuild(hv[j].x & 0xffff0000u, cwd, sh + 4), h1_rebuild(hv[j].y << 16, cwd, sh + 8), h1_rebuild(hv[j].y & 0xffff0000u, cwd, sh + 12)};
                  z[j] = h * DN_ALPHA + (f32x4){__uint_as_float(wv[j].x << 16), __uint_as_float(wv[j].x & 0xffff0000u), __uint_as_float(wv[j].y << 16), __uint_as_float(wv[j].y & 0xffff0000u)};
                  s += (z[j].x + z[j].y) + (z[j].z + z[j].w); } }
            const float mean = wave_sum(s) * (1.0f / DM); float q = 0.f;
#pragma unroll
            for (int j = 0; j < 8; ++j) { z[j] = z[j] - mean; q += (z[j].x * z[j].x + z[j].y * z[j].y) + (z[j].z * z[j].z + z[j].w * z[j].w); }
            float rstd = 1.0f / sqrtf(wave_sum(q) * (1.0f / DM) + LN_EPS);
            if (bad) rstd = __builtin_nanf("");
#pragma unroll
            for (int j = 0; j < 8; ++j) op[j] = (z[j] * rstd) * g1v[j] + b1v[j];
            rp = r;
        }
        if (rp >= 0) ROW_STORE3();
#undef ROW_STORE3
#undef ROW_DMA3
    }
#undef IN
#undef GRID_BAR
}

extern "C" void kernel_launch(void* const* d_in, const int* in_sizes, int n_in, void* d_out, int out_size, void* d_ws, size_t ws_size, hipStream_t stream) {
    static int grid = 0;
    if (grid == 0) {
        if (n_in != 15 || in_sizes[0] != M * DM || out_size != M * DM || ws_size < WS_END) {
            fprintf(stderr, "kernel_launch: built for 15 inputs, x/out of %d floats, >= %zu bytes of workspace; got n_in %d in0 %d out %d ws %zu\n", M * DM, (size_t)WS_END, n_in, n_in > 0 ? in_sizes[0] : -1, out_size, ws_size);
            grid = -1; return; }
        int dev = 0, cus = 0;
        if (hipGetDevice(&dev) != hipSuccess || hipDeviceGetAttribute(&cus, hipDeviceAttributeMultiprocessorCount, dev) != hipSuccess) { grid = -1; return; }
        if (hipFuncSetAttribute((const void*)hybrid_fwd, hipFuncAttributeMaxDynamicSharedMemorySize, LDS_BYTES) != hipSuccess) { fprintf(stderr, "kernel_launch: hipFuncSetAttribute failed\n"); grid = -1; return; }
        (void)hipGetLastError();
        grid = cus - cus % 8;
        if (grid != 256) fprintf(stderr, "kernel_launch: note: %d CUs (tuned for 256)\n", grid);
    }
    if (grid < 0) return;
    if (hipMemsetAsync((char*)d_ws + WS_CTL, 0, CTL_ZERO_BYTES, stream) != hipSuccess) { fprintf(stderr, "kernel_launch: hipMemsetAsync failed\n"); return; }
    Args a{};
    for (int i = 0; i < 15; ++i) a.in[i] = (const float*)d_in[i];
    a.out = (float*)d_out; a.ws = (unsigned char*)d_ws; a.ph_lo = 0; a.ph_hi = 9;
    hipLaunchKernelGGL(hybrid_fwd, dim3(grid), dim3(NWAVES * 64), LDS_BYTES, stream, a);
    const hipError_t le = hipPeekAtLastError();
    if (le != hipSuccess) fprintf(stderr, "kernel_launch: launch failed: %s\n", hipGetErrorName(le));
}
```

```cpp
#include <hip/hip_runtime.h>
#include <cstdio>
#include <cstdint>
__device__ __forceinline__ int lane_id_mb() { int l; asm volatile("v_mbcnt_lo_u32_b32 %0, -1, 0\n\tv_mbcnt_hi_u32_b32 %0, -1, %0" : "=v"(l)); return l; }
__device__ __forceinline__ int wg_tid(int wave_s) { return wave_s * 64 + lane_id_mb(); }
namespace pg8 {
#define PG8_LAS __attribute__((address_space(3)))
typedef unsigned short bf16_t;
typedef short bf16x8 __attribute__((ext_vector_type(8)));
typedef float f32x4 __attribute__((ext_vector_type(4)));
typedef unsigned u32x4 __attribute__((ext_vector_type(4)));
constexpr int BM = 256, BK = 64, HALF = 128, HTB = HALF * BK * 2  , STAGE_BYTES = 8 * HTB, NXCD = 8, WGM = 8;

__host__ __device__ __forceinline__ int lds_byte(int r, int c) { const int st = (r >> 4) * 2 + (c >> 5), rr = r & 15, cc = c & 31, ob = rr * 64 + cc * 2; return st * 1024 + (ob ^ (((ob >> 9) & 1) << 5)); }
__host__ __device__ __forceinline__ void stage_rc(int b, int& R, int& C) { const int st = b / 1024, sb = b % 1024, swz = sb ^ (((sb >> 9) & 1) << 5); R = (st >> 1) * 16 + swz / 64; C = (st & 1) * 32 + (swz % 64) / 2; }
__host__ __device__ __forceinline__ int perm32(int rho) { const int n = rho >> 4, i = rho & 15; return 8 * (i >> 2) + 4 * n + (i & 3); }

struct Unit { int pm, pn; };
struct Gemm { const bf16_t* A; const bf16_t* Bt; int M, N, K; int sA, sB; };
typedef int i32x4 __attribute__((ext_vector_type(4)));
typedef int i32x8 __attribute__((ext_vector_type(8)));
__device__ __forceinline__ i32x8 cat8(bf16x8 lo, bf16x8 hi) { return __builtin_shufflevector(__builtin_bit_cast(i32x4, lo), __builtin_bit_cast(i32x4, hi), 0, 1, 2, 3, 4, 5, 6, 7); }

struct StaticOrder {
    int nM, nN, nwg, G, c;
    __host__ __device__ void init(int M, int N, int G_, int c_) { nM = M / BM; nN = N / BM; nwg = nM * nN; G = G_; c = c_; }
    __host__ __device__ bool next(int i, Unit& u) const {
        const long L = (long)i * G + c; if (L >= nwg) return false;
        int wgid = (int)L; { const int q = nwg / NXCD, r = nwg % NXCD, xcd = wgid % NXCD, off = wgid / NXCD; wgid = (xcd < r ? xcd * (q + 1) : r * (q + 1) + (xcd - r) * q) + off; }
        const int nig = WGM * nN, gid = wgid / nig, fm = gid * WGM, gsz = (nM - fm) < WGM ? (nM - fm) : WGM;
        u.pm = fm + ((wgid % nig) % gsz); u.pn = (wgid % nig) / gsz; return true;
    }
    __device__ __forceinline__ void a_ready(const Unit&) const {}
    __device__ __forceinline__ void done(const Unit&) const {}
};

__device__ __forceinline__ unsigned cvt_pk_bf16(float lo, float hi) { unsigned r; asm volatile("v_cvt_pk_bf16_f32 %0, %1, %2" : "=v"(r) : "v"(lo), "v"(hi)); return r; }
template <int ACT  > struct EpiBf16 {
    static constexpr bool PERM = true, AFTER_DRAIN = false; static constexpr int EPI_STORES = 16  ; static_assert(ACT == 0, "EpiBf16: ACT is 0 (none)");
    bf16_t* O; int ldc; const float* bias; int split_cols; size_t split_stride; float scale0; int act_tile; int q8_tiles; int roff  ;
    __device__ __forceinline__ void operator()(const f32x4 (&acc)[2][2][4][2], const Unit& u, int wr, int wc, int fr, int fq) const {
        const int row0 = roff + u.pm * BM + wr * 64 + fr; int colt = u.pn * BM; bf16_t* base = O;
        float sc = 1.f; bool act = false, f8 = false; if (split_cols) { const int t = colt / split_cols; base += (size_t)t * split_stride; colt -= t * split_cols; if (t == 0) sc = scale0; if (t == 2 && q8_tiles > 2) sc = 8.0f; act = (t == act_tile); f8 = (t < q8_tiles); }
        const int col0 = colt + wc * 32 + 8 * fq, bcol0 = u.pn * BM + wc * 32 + 8 * fq;
        f32x4 bv[2][2];
#pragma unroll
        for (int bj = 0; bj < 2; ++bj)
#pragma unroll
            for (int n = 0; n < 2; ++n) bv[bj][n] = (f32x4){0.f, 0.f, 0.f, 0.f};
        if (f8) {
            unsigned char* b8 = (unsigned char*)base + (size_t)(row0 + ((fq & 1) ? 16 : 0)) * ldc + (col0 - ((fq & 1) ? 8 : 0));
#pragma unroll
            for (int ai = 0; ai < 2; ++ai)
#pragma unroll
                for (int bj = 0; bj < 2; ++bj)
#pragma unroll
                    for (int mp = 0; mp < 2; ++mp) { int wa0 = 0, wa1 = 0, wb0 = 0, wb1 = 0;
                        { const f32x4 v0 = acc[ai][bj][2 * mp][0] * sc, v1 = acc[ai][bj][2 * mp][1] * sc;
                          wa0 = __builtin_amdgcn_cvt_pk_fp8_f32(v0[0], v0[1], wa0, false); wa0 = __builtin_amdgcn_cvt_pk_fp8_f32(v0[2], v0[3], wa0, true);
                          wa1 = __builtin_amdgcn_cvt_pk_fp8_f32(v1[0], v1[1], wa1, false); wa1 = __builtin_amdgcn_cvt_pk_fp8_f32(v1[2], v1[3], wa1, true); }
                        { const f32x4 v0 = acc[ai][bj][2 * mp + 1][0] * sc, v1 = acc[ai][bj][2 * mp + 1][1] * sc;
                          wb0 = __builtin_amdgcn_cvt_pk_fp8_f32(v0[0], v0[1], wb0, false); wb0 = __builtin_amdgcn_cvt_pk_fp8_f32(v0[2], v0[3], wb0, true);
                          wb1 = __builtin_amdgcn_cvt_pk_fp8_f32(v1[0], v1[1], wb1, false); wb1 = __builtin_amdgcn_cvt_pk_fp8_f32(v1[2], v1[3], wb1, true); }
                        const auto r0 = __builtin_amdgcn_permlane16_swap((unsigned)wa0, (unsigned)wb0, false, false), r1 = __builtin_amdgcn_permlane16_swap((unsigned)wa1, (unsigned)wb1, false, false);
                        *(u32x4*)(b8 + (size_t)(ai * HALF + 32 * mp) * ldc + bj * HALF) = (u32x4){r0[0], r1[0], r0[1], r1[1]}; }
            return; }
#pragma unroll
        for (int ai = 0; ai < 2; ++ai)
#pragma unroll
            for (int m = 0; m < 4; ++m) { bf16_t* rowp = base + (size_t)(row0 + ai * HALF + m * 16) * ldc + col0;
#pragma unroll
                for (int bj = 0; bj < 2; ++bj) { f32x4 v0 = acc[ai][bj][m][0] + bv[bj][0], v1 = acc[ai][bj][m][1] + bv[bj][1];
                    if (act) {
#pragma unroll
                        for (int j = 0; j < 4; ++j) { v0[j] = v0[j] * __builtin_amdgcn_rcpf(1.0f + __builtin_amdgcn_exp2f(-1.4426950408889634f * v0[j])); v1[j] = v1[j] * __builtin_amdgcn_rcpf(1.0f + __builtin_amdgcn_exp2f(-1.4426950408889634f * v1[j])); } }
                    v0 = v0 * sc; v1 = v1 * sc;
                    if (f8) { int w0 = 0, w1 = 0;
                        w0 = __builtin_amdgcn_cvt_pk_fp8_f32(v0[0], v0[1], w0, false); w0 = __builtin_amdgcn_cvt_pk_fp8_f32(v0[2], v0[3], w0, true);
                        w1 = __builtin_amdgcn_cvt_pk_fp8_f32(v1[0], v1[1], w1, false); w1 = __builtin_amdgcn_cvt_pk_fp8_f32(v1[2], v1[3], w1, true);
                        typedef unsigned u32x2e __attribute__((ext_vector_type(2)));
                        *(u32x2e*)((unsigned char*)base + (size_t)(row0 + ai * HALF + m * 16) * ldc + col0 + bj * HALF) = (u32x2e){(unsigned)w0, (unsigned)w1};
                    } else { u32x4 w; w.x = cvt_pk_bf16(v0[0], v0[1]); w.y = cvt_pk_bf16(v0[2], v0[3]); w.z = cvt_pk_bf16(v1[0], v1[1]); w.w = cvt_pk_bf16(v1[2], v1[3]);
                        *(u32x4*)(rowp + bj * HALF) = w; } } }
    }
};
template <class Epi, class Sched, bool ALIGN_EPI = false, bool SP2 = false, bool FP8 = false>
__device__ __forceinline__ void gemm_phase(PG8_LAS unsigned char* lds, const Gemm g, const Sched& S, const Epi& E, int wv) {
    int tid_ = wg_tid(wv); asm volatile("" : "+v"(tid_));
    const int tid = tid_, wid = __builtin_amdgcn_readfirstlane(tid >> 6), lane = tid & 63, wr = wid >> 2, wc = wid & 3, fr = lane & 15, fq = lane >> 4;
    const int K = g.K, nt = K / BK;
    unsigned voffA[2], voffB[2];
#pragma unroll
    for (int i = 0; i < 2; ++i) { int R, C; stage_rc(tid * 16 + i * 8192, R, C); const int Rb = Epi::PERM ? ((R & ~31) + perm32(R & 31)) : R;
        voffA[i] = (unsigned)(R * K + C) * 2u; voffB[i] = (unsigned)(Rb * K + C) * 2u; }
    const unsigned rstep64 = 64u * (unsigned)K * 2u;
    const unsigned kstep = (unsigned)(BK * 2);
    const unsigned hstep = (unsigned)HALF * K * 2;
    const unsigned tstep = 2 * hstep;
    const unsigned ldsw = (unsigned)wid * 1024u;
    const int aoff = lds_byte(wr * 64 + fr, fq * 8), boff = lds_byte(wc * 32 + fr, fq * 8);
#define PG8_SA(b, h) (((b) * 2 + (h)) * HTB)
#define PG8_SB(b, h) ((4 + (b) * 2 + (h)) * HTB)
#define PG8_STAGE(bufoff, goff, voff) do { _Pragma("unroll") for (int _i = 0; _i < 2; ++_i) \
        __builtin_amdgcn_raw_ptr_buffer_load_lds((&(voff)[0] == &voffA[0]) ? rA : rB, (PG8_LAS void*)(lds + (bufoff) + ldsw + _i * 8192), 16, (int)(voff)[0], (int)((goff) + (unsigned)_i * rstep64), 0, 0); } while (0)
#define PG8_LDA(dst, b, h) do { _Pragma("unroll") for (int m = 0; m < 4; ++m) { if constexpr (FP8) dst##8[m] = cat8(*(const PG8_LAS bf16x8*)(lds + PG8_SA(b, h) + aoff + m * 2048), *(const PG8_LAS bf16x8*)(lds + PG8_SA(b, h) + aoff + m * 2048 + 1024)); \
        else { _Pragma("unroll") for (int k = 0; k < 2; ++k) dst[m][k] = *(const PG8_LAS bf16x8*)(lds + PG8_SA(b, h) + aoff + m * 2048 + k * 1024); } } } while (0)
#define PG8_LDB(dst, b, h) do { _Pragma("unroll") for (int n = 0; n < 2; ++n) { if constexpr (FP8) dst##8[n] = cat8(*(const PG8_LAS bf16x8*)(lds + PG8_SB(b, h) + boff + n * 2048), *(const PG8_LAS bf16x8*)(lds + PG8_SB(b, h) + boff + n * 2048 + 1024)); \
        else { _Pragma("unroll") for (int k = 0; k < 2; ++k) dst[n][k] = *(const PG8_LAS bf16x8*)(lds + PG8_SB(b, h) + boff + n * 2048 + k * 1024); } } } while (0)
#define PG8_MMA(ai, bj, At, Bt) do { __builtin_amdgcn_s_setprio(1); _Pragma("unroll") for (int m = 0; m < 4; ++m) _Pragma("unroll") for (int n = 0; n < 2; ++n) { \
        if constexpr (FP8) acc[ai][bj][m][n] = __builtin_amdgcn_mfma_scale_f32_16x16x128_f8f6f4(Bt##8[n], At##8[m], acc[ai][bj][m][n], 0, 0, 0, g.sB, 0, g.sA); \
        else { _Pragma("unroll") for (int k = 0; k < 2; ++k) acc[ai][bj][m][n] = __builtin_amdgcn_mfma_f32_16x16x32_bf16(Bt[n][k], At[m][k], acc[ai][bj][m][n], 0, 0, 0); } } __builtin_amdgcn_s_setprio(0); } while (0)
#define PG8_WAIT_V(n) asm volatile("s_waitcnt vmcnt(" #n ")" ::: "memory")
#define PG8_WAIT_L(n) asm volatile("s_waitcnt lgkmcnt(" #n ")" ::: "memory")
#define PG8_BAR __builtin_amdgcn_s_barrier()
#define PG8_SCHED __builtin_amdgcn_sched_barrier(0)
    Unit cur, nxt; int ui = 0;
    if (!S.next(0, cur)) return;
    f32x4 acc[2][2][4][2];
#pragma unroll
    for (int a = 0; a < 2; ++a)
#pragma unroll
        for (int b = 0; b < 2; ++b)
#pragma unroll
            for (int m = 0; m < 4; ++m)
#pragma unroll
                for (int n = 0; n < 2; ++n) acc[a][b][m][n] = (f32x4){0.f, 0.f, 0.f, 0.f};
    bf16x8 At[4][2], B0[2][2], B1[2][2]; i32x8 At8[4], B08[2], B18[2];
    const __amdgpu_buffer_rsrc_t rA = __builtin_amdgcn_make_buffer_rsrc((void*)g.A, 0, (int)((unsigned)g.M * (unsigned)K * 2u), 0x00020000), rB = __builtin_amdgcn_make_buffer_rsrc((void*)g.Bt, 0, (int)((unsigned)g.N * (unsigned)K * 2u), 0x00020000);
    unsigned cA = (unsigned)cur.pm * tstep, cB = (unsigned)cur.pn * tstep;
    S.a_ready(cur);
    if constexpr (SP2) {
        PG8_STAGE(PG8_SB(0, 0), cB, voffB); PG8_STAGE(PG8_SB(0, 1), cB + hstep, voffB); PG8_STAGE(PG8_SA(0, 0), cA, voffA); PG8_STAGE(PG8_SA(0, 1), cA + hstep, voffA);
        if (wr == 1) PG8_BAR;
        PG8_WAIT_V(2); PG8_BAR;
        PG8_STAGE(PG8_SB(1, 0), cB + kstep, voffB); PG8_STAGE(PG8_SA(1, 0), cA + kstep, voffA); PG8_STAGE(PG8_SB(1, 1), cB + hstep + kstep, voffB);
        PG8_WAIT_V(6); PG8_BAR;
    } else {
        PG8_STAGE(PG8_SB(0, 0), cB, voffB); PG8_STAGE(PG8_SA(0, 0), cA, voffA); PG8_STAGE(PG8_SB(0, 1), cB + hstep, voffB); PG8_STAGE(PG8_SA(0, 1), cA + hstep, voffA);
        if (wr == 1) PG8_BAR;
        PG8_WAIT_V(4); PG8_BAR;
        PG8_STAGE(PG8_SB(1, 0), cB + kstep, voffB); PG8_STAGE(PG8_SA(1, 0), cA + kstep, voffA); PG8_STAGE(PG8_SB(1, 1), cB + hstep + kstep, voffB);
        PG8_WAIT_V(6); PG8_BAR;
    }
    for (;;) {
        const bool has_next = S.next(ui + 1, nxt);
        const unsigned nA = has_next ? (unsigned)nxt.pm * tstep : cA, nB = has_next ? (unsigned)nxt.pn * tstep : cB;
        for (int t = 0; t < nt; t += 2) {
            const bool last = (t == nt - 2);
            const unsigned a1 = cA + (unsigned)(t + 1) * kstep;
            const unsigned a2 = last ? nA : cA + (unsigned)(t + 2) * kstep, b2 = last ? nB : cB + (unsigned)(t + 2) * kstep;
            const unsigned a3 = a2 + kstep, b3 = b2 + kstep;
            if (last && has_next) S.a_ready(nxt);
            if constexpr (SP2) {
            PG8_LDB(B0, 0, 0); PG8_LDB(B1, 0, 1); PG8_SCHED; PG8_LDA(At, 0, 0); PG8_STAGE(PG8_SA(1, 1), a1 + hstep, voffA);
            PG8_WAIT_V(8);
            PG8_WAIT_L(0); PG8_BAR; PG8_MMA(0, 0, At, B0); PG8_MMA(0, 1, At, B1); PG8_BAR; PG8_SCHED;
            PG8_LDA(At, 0, 1); PG8_STAGE(PG8_SB(0, 0), b2, voffB); PG8_STAGE(PG8_SB(0, 1), b2 + hstep, voffB); PG8_STAGE(PG8_SA(0, 0), a2, voffA);
            PG8_WAIT_V(8);
            PG8_WAIT_L(0); PG8_BAR; PG8_MMA(1, 0, At, B0); PG8_MMA(1, 1, At, B1); PG8_BAR; PG8_SCHED;
            PG8_LDB(B0, 1, 0); PG8_LDB(B1, 1, 1); PG8_SCHED; PG8_LDA(At, 1, 0); PG8_STAGE(PG8_SA(0, 1), a2 + hstep, voffA);
            PG8_WAIT_V(8); PG8_WAIT_L(0); PG8_BAR; PG8_MMA(0, 0, At, B0); PG8_MMA(0, 1, At, B1); PG8_BAR; PG8_SCHED;
            PG8_LDA(At, 1, 1); PG8_STAGE(PG8_SB(1, 0), b3, voffB); PG8_STAGE(PG8_SB(1, 1), b3 + hstep, voffB); PG8_STAGE(PG8_SA(1, 0), a3, voffA);
            PG8_WAIT_V(8); PG8_WAIT_L(0); PG8_BAR; PG8_MMA(1, 0, At, B0); PG8_MMA(1, 1, At, B1); PG8_BAR; PG8_SCHED;
            } else {
            PG8_LDB(B0, 0, 0); PG8_SCHED; PG8_LDA(At, 0, 0); PG8_STAGE(PG8_SA(1, 1), a1 + hstep, voffA);
            PG8_WAIT_L(8); PG8_BAR; PG8_WAIT_L(0); PG8_MMA(0, 0, At, B0); PG8_BAR; PG8_SCHED;
            PG8_LDB(B1, 0, 1); PG8_STAGE(PG8_SB(0, 0), b2, voffB);
            PG8_BAR; PG8_WAIT_L(0); PG8_MMA(0, 1, At, B1); PG8_BAR;
            PG8_LDA(At, 0, 1); PG8_STAGE(PG8_SA(0, 0), a2, voffA);
            PG8_BAR; PG8_WAIT_L(0); PG8_MMA(1, 0, At, B0); PG8_BAR; PG8_SCHED;
            PG8_STAGE(PG8_SB(0, 1), b2 + hstep, voffB);
            PG8_WAIT_V(6); PG8_BAR; PG8_MMA(1, 1, At, B1); PG8_BAR;
            PG8_LDB(B0, 1, 0); PG8_SCHED; PG8_LDA(At, 1, 0); PG8_STAGE(PG8_SA(0, 1), a2 + hstep, voffA);
            PG8_WAIT_L(8); PG8_BAR; PG8_WAIT_L(0); PG8_MMA(0, 0, At, B0); PG8_BAR; PG8_SCHED;
            PG8_LDB(B1, 1, 1); PG8_STAGE(PG8_SB(1, 0), b3, voffB);
            PG8_BAR; PG8_WAIT_L(0); PG8_MMA(0, 1, At, B1); PG8_BAR;
            PG8_LDA(At, 1, 1); PG8_STAGE(PG8_SA(1, 0), a3, voffA);
            PG8_BAR; PG8_WAIT_L(0); PG8_MMA(1, 0, At, B0); PG8_BAR; PG8_SCHED;
            PG8_STAGE(PG8_SB(1, 1), b3 + hstep, voffB);
            PG8_WAIT_V(6); PG8_BAR; PG8_MMA(1, 1, At, B1); PG8_BAR;
            }
        }
        if constexpr (ALIGN_EPI) { if (wr == 0) PG8_BAR; }
        if constexpr (!Epi::AFTER_DRAIN) { const int ln_ = lane_id_mb(); E(acc, cur, wr, wc, ln_ & 15, ln_ >> 4); S.done(cur); }
        if (!has_next) break;
#pragma unroll
        for (int a = 0; a < 2; ++a)
#pragma unroll
            for (int b = 0; b < 2; ++b)
#pragma unroll
                for (int m = 0; m < 4; ++m)
#pragma unroll
                    for (int n = 0; n < 2; ++n) acc[a][b][m][n] = (f32x4){0.f, 0.f, 0.f, 0.f};
        cur = nxt; cA = nA; cB = nB; ++ui;
        if constexpr (ALIGN_EPI) { if (wr == 1) PG8_BAR; }
    }
    PG8_WAIT_V(0);
    if constexpr (!ALIGN_EPI) { if (wr == 0) PG8_BAR; }
    PG8_BAR;
    if constexpr (Epi::AFTER_DRAIN) { E.fused(acc, cur, wr, wc, fr, fq, lds, wid, lane); S.done(cur); }
#undef PG8_SA
#undef PG8_SB
#undef PG8_STAGE
#undef PG8_LDA
#undef PG8_LDB
#undef PG8_MMA
#undef PG8_WAIT_V
#undef PG8_WAIT_L
#undef PG8_BAR
#undef PG8_SCHED
}
}

namespace att {
typedef short bf16x8 __attribute__((ext_vector_type(8)));
typedef short s16x4 __attribute__((ext_vector_type(4)));
typedef float f32x16 __attribute__((ext_vector_type(16)));
typedef float f32x4a __attribute__((ext_vector_type(4)));
typedef unsigned u32x4 __attribute__((ext_vector_type(4)));
typedef unsigned u32x2 __attribute__((ext_vector_type(2)));
#define ATT_LAS __attribute__((address_space(3)))
constexpr int SEQ = 2048, PITCH = 2048, NQG = 8;
typedef int i32x8a __attribute__((ext_vector_type(8)));
__device__ __forceinline__ i32x8a cat4(long a, long b, long c, long d) { return (i32x8a){(int)a, (int)(a >> 32), (int)b, (int)(b >> 32), (int)c, (int)(c >> 32), (int)d, (int)(d >> 32)}; }
constexpr int KVB = 16384;
constexpr int KB8 = 8192;
constexpr int LDS_V = 0, LDS_K = 8 * KB8;
constexpr int STG_STRIDE = 272, STG_WAVE = 32 * STG_STRIDE;
constexpr int TL_N = 640;
constexpr float THR = 6.0f;
__device__ __forceinline__ unsigned cvtpk(float lo, float hi) { unsigned r; asm volatile("v_cvt_pk_bf16_f32 %0, %1, %2" : "=v"(r) : "v"(lo), "v"(hi)); return r; }
__device__ __forceinline__ int kswz(int row, int colB) { return row * 256 + (colB ^ ((row & 7) << 4)); }
__device__ __forceinline__ int v_st(int k, int c) { return ((k >> 3) * 4 + (c >> 5)) * 512 + ((k & 7) * 32 + (c & 31)) * 2; }
__device__ __forceinline__ int v_rd_base(int lane) { return ((lane & 3) << 3) | (((lane >> 2) & 3) << 6) | (((lane >> 4) & 1) << 5) | (((lane >> 5) & 1) << 8); }
typedef short v4i16_t __attribute__((ext_vector_type(4)));
__device__ __forceinline__ s16x4 vtr(const ATT_LAS char* p) { return __builtin_bit_cast(s16x4, __builtin_amdgcn_ds_read_tr16_b64_v4i16((ATT_LAS v4i16_t*)p)); }
#define ATT_PK(L, H) (bf16x8){L[0], L[1], L[2], L[3], H[0], H[1], H[2], H[3]}
template <int OFF> __device__ __forceinline__ s16x4 tr_read(int vb) { s16x4 r; asm volatile("ds_read_b64_tr_b16 %0, %1 offset:%2" : "=&v"(r) : "v"(vb), "i"(OFF) : "memory"); return r; }
template <int D0> __device__ __forceinline__ void pv_one(f32x16& od, int vb, bf16x8 pb0, bf16x8 pb1, bf16x8 pb2, bf16x8 pb3) {
    const s16x4 l0 = tr_read<D0 * 512 + 0 * 4096>(vb), h0 = tr_read<D0 * 512 + 0 * 4096 + 2048>(vb), l1 = tr_read<D0 * 512 + 1 * 4096>(vb), h1 = tr_read<D0 * 512 + 1 * 4096 + 2048>(vb);
    const s16x4 l2 = tr_read<D0 * 512 + 2 * 4096>(vb), h2 = tr_read<D0 * 512 + 2 * 4096 + 2048>(vb), l3 = tr_read<D0 * 512 + 3 * 4096>(vb), h3 = tr_read<D0 * 512 + 3 * 4096 + 2048>(vb);
    asm volatile("s_waitcnt lgkmcnt(0)" ::: "memory"); __builtin_amdgcn_sched_barrier(0);
    od = __builtin_amdgcn_mfma_f32_32x32x16_bf16(ATT_PK(l0, h0), pb0, od, 0, 0, 0);
    od = __builtin_amdgcn_mfma_f32_32x32x16_bf16(ATT_PK(l1, h1), pb1, od, 0, 0, 0);
    od = __builtin_amdgcn_mfma_f32_32x32x16_bf16(ATT_PK(l2, h2), pb2, od, 0, 0, 0);
    od = __builtin_amdgcn_mfma_f32_32x32x16_bf16(ATT_PK(l3, h3), pb3, od, 0, 0, 0);
}
struct Tensors { const unsigned short* Q; const unsigned short* K; const unsigned short* V; const unsigned short* G; unsigned short* O; const float* table; };

__device__ __forceinline__ void attn_bh(ATT_LAS unsigned char* lds, ATT_LAS float* tl, const Tensors& T, int b, int h, int wv) {
    int tid_ = wg_tid(wv); asm volatile("" : "+v"(tid_));
    const int tid = tid_, lane = tid & 63, r32 = lane & 31, hi = lane >> 5; const int wid = __builtin_amdgcn_readfirstlane(tid >> 6);
    for (int e = tid; e < TL_N; e += 512) { int d = 575 - e; d = d > 256 ? 256 : d; d = d < -256 ? -256 : d; tl[e] = T.table[h * 513 + d + 256] * 1.4426950408889634f; }
    const int ci = wid < 4 ? wid : 7 - wid, hf = wid >> 2;
    const size_t rowb = (size_t)b * SEQ;
    const unsigned hbase = (unsigned)(rowb * PITCH + h * 128) * 2u;
    const __amdgpu_buffer_rsrc_t rK = __builtin_amdgcn_make_buffer_rsrc((void*)T.K, 0, (int)(32768u * PITCH), 0x00020000), rV = __builtin_amdgcn_make_buffer_rsrc((void*)T.V, 0, (int)(32768u * PITCH), 0x00020000);
    unsigned koff0, koff1, voff0, voff1;
    { const int l16 = lane & 15, rq = lane >> 4;
      { const int row = 8 * wid + (lane >> 3); koff0 = (unsigned)(row * PITCH + (((lane & 7) ^ ((row >> 1) & 7)) << 4)); koff1 = 0u; (void)l16; (void)rq; }
      { const int row = 8 * wid + (lane >> 3), c16 = lane & 7, fv = ((row >> 1) & 1) | (((row >> 3) & 1) << 1);
        voff0 = (unsigned)(row * PITCH + (((c16 & 1) | (((c16 >> 1) ^ fv) << 1)) << 4)); voff1 = 0u; } }
    int vbase8[4];
    { const int g_ = lane >> 4, i_ = lane & 15; const int q_ = i_ >> 1, p_ = i_ & 1; const int h_ = g_ >> 1, kr0 = q_ < 4 ? 4 * h_ + q_ : 8 + 4 * h_ + (q_ - 4), fv = ((kr0 >> 1) & 1) | (((kr0 >> 3) & 1) << 1);
#pragma unroll
      for (int d0 = 0; d0 < 4; ++d0) { vbase8[d0] = (int)(unsigned)(uintptr_t)(lds + LDS_V) + kr0 * 128 + ((d0 ^ fv) << 5) + 16 * (g_ & 1) + 8 * p_; asm volatile("" : "+v"(vbase8[d0])); } }
    int kbase[8];
#pragma unroll
    for (int j = 0; j < 8; ++j) { kbase[j] = r32 * 128 + ((j ^ ((r32 >> 1) & 7)) << 4) + 8 * hi; asm volatile("" : "+v"(kbase[j])); }
#define ATT_DMA(t, slot) do { const int so_ = (int)(hbase + (unsigned)(t) * (64u * PITCH * 2u)); \
        __builtin_amdgcn_raw_ptr_buffer_load_lds(rK, (ATT_LAS void*)(lds + LDS_K + (slot) * KB8 + 1024 * wid), 16, (int)koff0, (int)((unsigned)so_ >> 1), 0, 0); \
        __builtin_amdgcn_raw_ptr_buffer_load_lds(rV, (ATT_LAS void*)(lds + LDS_V + (slot) * KB8 + 1024 * wid), 16, (int)voff0, (int)((unsigned)so_ >> 1), 0, 0); } while (0)
#define ATT_BAR(N) do { asm volatile("s_waitcnt vmcnt(" #N ") lgkmcnt(0)" ::: "memory"); __builtin_amdgcn_s_barrier(); asm volatile("" ::: "memory"); } while (0)
    ATT_BAR(0);
    long qr[8];
#define ATT_QLOAD(qw0_) do { const unsigned char* Qw = (const unsigned char*)T.Q + (rowb + (qw0_) + r32) * PITCH + h * 128 + hi * 8; \
        _Pragma("unroll") for (int d0 = 0; d0 < 8; ++d0) qr[d0] = *(const long*)(Qw + d0 * 16); } while (0)
    ATT_QLOAD(ci * 64 + hf * 32); ATT_DMA(0, 0); ATT_DMA(1, 1); ATT_DMA(2, 2); ATT_DMA(3, 3);
#pragma unroll
    for (int d0 = 0; d0 < 8; ++d0) asm volatile("" : "+v"(qr[d0]));
    ATT_BAR(0);
    for (int qg = 0; qg < NQG; ++qg) {
        const int c0 = 4 * qg, t_lo = c0 - 8 > 0 ? c0 - 8 : 0, t_hi = c0 + 3;
        const int c = c0 + ci, my_lo = c - 8 > 0 ? c - 8 : 0, my_hi = c;
        const int qw0 = c * 64 + hf * 32;
        float m_reg = -1e30f, l_reg = 0.f; f32x16 o[4];
#pragma unroll
        for (int d = 0; d < 4; ++d)
#pragma unroll
            for (int r = 0; r < 16; ++r) o[d][r] = 0.f;
        const int D = c0 >= 8 ? 3 : 0, nsteps = (c0 + 3 < 8 ? c0 + 3 : 8) + 1, rmax = t_hi - t_lo;
        int next_r = 4;
        for (int jp = 0; jp < nsteps; jp += (jp == 0 ? 1 : 2)) {
            const int cnt = jp == 0 ? 1 : 2;
            for (; next_r <= rmax && next_r <= jp + 7; ++next_r) ATT_DMA(t_lo + next_r, next_r & 7);
          for (int u = 0; u < cnt; ++u) { const int j = jp + u; if (j >= nsteps) break; const int t = my_lo + j, slot = (t - t_lo) & 7;
            if (t >= my_lo && t <= my_hi) {
                const ATT_LAS float* tb = tl + (575 - (qw0 - t * 64) - r32 + 4 * hi);
                f32x16 p0, p1;
#pragma unroll
                for (int r = 0; r < 16; ++r) { p0[r] = tb[(r & 3) + 8 * (r >> 2)]; p1[r] = tb[32 + (r & 3) + 8 * (r >> 2)]; }
                const int kbo = slot * KB8;
                long kf0[8], kf1[8];
#pragma unroll
                for (int d0 = 0; d0 < 8; ++d0) { const ATT_LAS char* kp_ = (const ATT_LAS char*)lds + LDS_K + kbase[d0] + kbo;
                    kf0[d0] = *(const ATT_LAS long*)(kp_); kf1[d0] = *(const ATT_LAS long*)(kp_ + 4096); }
                __builtin_amdgcn_sched_barrier(0);
#pragma unroll
                for (int s = 0; s < 2; ++s) { const i32x8a qq = cat4(qr[4 * s], qr[4 * s + 1], qr[4 * s + 2], qr[4 * s + 3]);
                    p0 = __builtin_amdgcn_mfma_scale_f32_32x32x64_f8f6f4(cat4(kf0[4 * s], kf0[4 * s + 1], kf0[4 * s + 2], kf0[4 * s + 3]), qq, p0, 0, 0, 0, 0x7f7f7f7f, 0, 0x7f7f7f7f);
                    p1 = __builtin_amdgcn_mfma_scale_f32_32x32x64_f8f6f4(cat4(kf1[4 * s], kf1[4 * s + 1], kf1[4 * s + 2], kf1[4 * s + 3]), qq, p1, 0, 0, 0, 0x7f7f7f7f, 0, 0x7f7f7f7f); }
                __builtin_amdgcn_sched_barrier(0);
                float pmax = p0[0];
#pragma unroll
                for (int r = 1; r < 16; ++r) pmax = fmaxf(pmax, p0[r]);
#pragma unroll
                for (int r = 0; r < 16; ++r) pmax = fmaxf(pmax, p1[r]);
                { auto rr = __builtin_amdgcn_permlane32_swap(__float_as_uint(pmax), __float_as_uint(pmax), false, false); pmax = fmaxf(__uint_as_float(rr[0]), __uint_as_float(rr[1])); }
                if (!__all(pmax - m_reg <= THR)) {
                    const float mn = fmaxf(m_reg, pmax), alpha = __builtin_amdgcn_exp2f(m_reg - mn); m_reg = mn; l_reg *= alpha;
#pragma unroll
                    for (int d = 0; d < 4; ++d)
#pragma unroll
                        for (int r = 0; r < 16; ++r) o[d][r] *= alpha;
                }
                float ps0 = 0.f, ps1 = 0.f, ps2 = 0.f, ps3 = 0.f;
#pragma unroll
                for (int r = 0; r < 16; r += 4) { p0[r] = __builtin_amdgcn_exp2f(p0[r] - m_reg); ps0 += p0[r]; p0[r + 1] = __builtin_amdgcn_exp2f(p0[r + 1] - m_reg); ps1 += p0[r + 1];
                    p0[r + 2] = __builtin_amdgcn_exp2f(p0[r + 2] - m_reg); ps2 += p0[r + 2]; p0[r + 3] = __builtin_amdgcn_exp2f(p0[r + 3] - m_reg); ps3 += p0[r + 3]; }
#pragma unroll
                for (int r = 0; r < 16; r += 4) { p1[r] = __builtin_amdgcn_exp2f(p1[r] - m_reg); ps0 += p1[r]; p1[r + 1] = __builtin_amdgcn_exp2f(p1[r + 1] - m_reg); ps1 += p1[r + 1];
                    p1[r + 2] = __builtin_amdgcn_exp2f(p1[r + 2] - m_reg); ps2 += p1[r + 2]; p1[r + 3] = __builtin_amdgcn_exp2f(p1[r + 3] - m_reg); ps3 += p1[r + 3]; }
                l_reg += (ps0 + ps1) + (ps2 + ps3);
                long pb8[4];
#define ATT_PK8(P, B0) ({ int lo_ = 0, hi_ = 0; lo_ = __builtin_amdgcn_cvt_pk_fp8_f32(P[B0], P[B0 + 1], lo_, false); lo_ = __builtin_amdgcn_cvt_pk_fp8_f32(P[B0 + 2], P[B0 + 3], lo_, true); \
                    hi_ = __builtin_amdgcn_cvt_pk_fp8_f32(P[B0 + 4], P[B0 + 5], hi_, false); hi_ = __builtin_amdgcn_cvt_pk_fp8_f32(P[B0 + 6], P[B0 + 7], hi_, true); (long)(((unsigned long long)(unsigned)hi_ << 32) | (unsigned)lo_); })
                pb8[0] = ATT_PK8(p0, 0); pb8[1] = ATT_PK8(p0, 8); pb8[2] = ATT_PK8(p1, 0); pb8[3] = ATT_PK8(p1, 8);
#undef ATT_PK8
                const int vso = slot * KB8;
#pragma unroll
                for (int d0 = 0; d0 < 4; ++d0) { long vf[4];
#pragma unroll
                    for (int ks = 0; ks < 4; ++ks) asm volatile("ds_read_b64_tr_b8 %0, %1 offset:%2" : "=&v"(vf[ks]) : "v"(vbase8[d0] + vso), "i"(ks * 2048) : "memory");
                    asm volatile("s_waitcnt lgkmcnt(0)" ::: "memory"); __builtin_amdgcn_sched_barrier(0);
                    o[d0] = __builtin_amdgcn_mfma_scale_f32_32x32x64_f8f6f4(cat4(vf[0], vf[1], vf[2], vf[3]), cat4(pb8[0], pb8[1], pb8[2], pb8[3]), o[d0], 0, 0, 0, 0x7f7f7f7f, 0, 0x7f7f7f7f); }
            }
          }
            { const int jn = jp + cnt, need = jn + 1 + D < rmax ? jn + 1 + D : rmax; const int n = (next_r - 1) - need;
              if (n >= 4) ATT_BAR(8); else if (n == 3) ATT_BAR(6); else if (n == 2) ATT_BAR(4); else if (n == 1) ATT_BAR(2); else ATT_BAR(0); }
        }
        { auto rr = __builtin_amdgcn_permlane32_swap(__float_as_uint(l_reg), __float_as_uint(l_reg), false, false); l_reg = __uint_as_float(rr[0]) + __uint_as_float(rr[1]); }
        const float linv = 0.125f / l_reg;
        if (qg + 1 < NQG) { const int nt_lo = c0 + 4 - 8 > 0 ? c0 + 4 - 8 : 0;
            ATT_DMA(nt_lo, 0); ATT_DMA(nt_lo + 1, 1); ATT_DMA(nt_lo + 2, 2); ATT_DMA(nt_lo + 3, 3); ATT_QLOAD(qw0 + 256); }
        const size_t orow0 = rowb + qw0;
        u32x4 gv[8];
#pragma unroll
        for (int i = 0; i < 8; ++i) gv[i] = *(const u32x4*)(T.G + (orow0 + 4 * i + (lane >> 4)) * PITCH + h * 128 + (lane & 15) * 8);
        ATT_LAS unsigned char* stg = lds + (wid < 4 ? LDS_V + 4 * KB8 + wid * 8192 : LDS_K + 4 * KB8 + (wid - 4) * 8192);
#pragma unroll
        for (int d0 = 0; d0 < 4; ++d0)
#pragma unroll
            for (int rq = 0; rq < 4; ++rq) { u32x2 w; w.x = cvtpk(o[d0][4 * rq] * linv, o[d0][4 * rq + 1] * linv); w.y = cvtpk(o[d0][4 * rq + 2] * linv, o[d0][4 * rq + 3] * linv);
                *(ATT_LAS u32x2*)(stg + r32 * 256 + (((4 * d0 + rq) ^ (r32 & 15)) << 4) + 8 * hi) = w; }
        __builtin_amdgcn_fence(__ATOMIC_RELEASE, "wavefront"); asm volatile("s_waitcnt lgkmcnt(0)" ::: "memory");
#pragma unroll
        for (int i = 0; i < 8; ++i) { const int row = 4 * i + (lane >> 4), ch = lane & 15;
            const u32x4 ov = *(const ATT_LAS u32x4*)(stg + row * 256 + ((ch ^ (row & 15)) << 4));
            int r8[2] = {0, 0};
#pragma unroll
            for (int j = 0; j < 4; ++j) {
                const float o_lo = __uint_as_float(ov[j] << 16), o_hi = __uint_as_float(ov[j] & 0xffff0000u);
                const float g_lo = __uint_as_float(gv[i][j] << 16), g_hi = __uint_as_float(gv[i][j] & 0xffff0000u);
                const float s_lo = g_lo * __builtin_amdgcn_rcpf(1.0f + __builtin_amdgcn_exp2f(-1.4426950408889634f * g_lo));
                const float s_hi = g_hi * __builtin_amdgcn_rcpf(1.0f + __builtin_amdgcn_exp2f(-1.4426950408889634f * g_hi));
                const float e0 = o_lo * s_lo * 64.0f, e1 = o_hi * s_hi * 64.0f;
                if (j & 1) r8[j >> 1] = __builtin_amdgcn_cvt_pk_fp8_f32(e0, e1, r8[j >> 1], true); else r8[j >> 1] = __builtin_amdgcn_cvt_pk_fp8_f32(e0, e1, r8[j >> 1], false); }
            *(u32x2*)((unsigned char*)T.O + (orow0 + row) * PITCH + h * 128 + ch * 8) = (u32x2){(unsigned)r8[0], (unsigned)r8[1]}; }
        ATT_BAR(0);
    }
#undef ATT_QLOAD
#undef ATT_DMA
}
#undef ATT_PK
}

namespace lru {
typedef short bf16x8 __attribute__((ext_vector_type(8)));
typedef float f32x4l __attribute__((ext_vector_type(4)));
typedef unsigned u32x4 __attribute__((ext_vector_type(4)));
typedef unsigned u32x2 __attribute__((ext_vector_type(2)));
#define LRU_LAS __attribute__((address_space(3)))
constexpr int SEQ = 2048, PITCH = 2048, NT = 32;
constexpr int L_RAW = 0  , L_A = 34816, L_G = 51200  , L_SC = 83968  , RAWB = 17408;
constexpr float LOG2E = 1.4426950408889634f, LN2 = 0.6931471805599453f;
__device__ __forceinline__ unsigned cvtpk(float lo, float hi) { unsigned r; asm volatile("v_cvt_pk_bf16_f32 %0, %1, %2" : "=v"(r) : "v"(lo), "v"(hi)); return r; }
__device__ __forceinline__ float bf_lo(unsigned w) { return __uint_as_float(w << 16); }
__device__ __forceinline__ float bf_hi(unsigned w) { return __uint_as_float(w & 0xffff0000u); }
__device__ __forceinline__ float sigmoidf_fast(float x) { return __builtin_amdgcn_rcpf(1.0f + __builtin_amdgcn_exp2f(-LOG2E * x)); }
struct Params { const unsigned short* U; const unsigned short* G; unsigned short* Y;
    const float* conv_w; const float* conv_b; const float* wa; const float* ba; const float* wx; const float* bx; const float* lam; };

__device__ __forceinline__ void lru_bn(LRU_LAS unsigned char* lds, const Params& P, int b, int n, int wv) {
    int tid_ = wg_tid(wv); asm volatile("" : "+v"(tid_));
    const int tid = tid_, lane = tid & 63, nn = lane & 15, kq = lane >> 4; const int wid = __builtin_amdgcn_readfirstlane(tid >> 6);
    const size_t rowb = (size_t)b * SEQ;
    const unsigned short* Ub = P.U + rowb * PITCH + n * 128; const unsigned short* Gb = P.G + rowb * PITCH + n * 128; unsigned short* Yb = P.Y + rowb * PITCH + n * 128;
    bf16x8 Ba[4], Bx[4];
    { const float* wa0 = P.wa + (size_t)n * 128 * 128 + 16 * wid + nn; const float* wx0 = P.wx + (size_t)n * 128 * 128 + 16 * wid + nn;
#pragma unroll
      for (int ks = 0; ks < 4; ++ks) { u32x4 ta, tx;
#pragma unroll
          for (int j2 = 0; j2 < 4; ++j2) { const int i0 = 32 * ks + 8 * kq + 2 * j2;
              ta[j2] = cvtpk(-LOG2E * wa0[(size_t)i0 * 128], -LOG2E * wa0[(size_t)(i0 + 1) * 128]); tx[j2] = cvtpk(-LOG2E * wx0[(size_t)i0 * 128], -LOG2E * wx0[(size_t)(i0 + 1) * 128]); }
          Ba[ks] = __builtin_bit_cast(bf16x8, ta); Bx[ks] = __builtin_bit_cast(bf16x8, tx); } }
    const int chl = 16 * wid + nn, chg = n * 128 + chl;
    const float c_ba = -LOG2E * P.ba[chg], c_bx = -LOG2E * P.bx[chg];
    const float c_sp = -8.0f * log1pf(expf(-P.lam[chg])) * LOG2E;
    const int tt4 = tid >> 5, cg = tid & 31;
    f32x4l cw0, cw1, cw2, cw3, cbv;
    { const float* cwp = P.conv_w + n * 128 + 4 * cg; cw0 = *(const f32x4l*)(cwp); cw1 = *(const f32x4l*)(cwp + 2048); cw2 = *(const f32x4l*)(cwp + 4096); cw3 = *(const f32x4l*)(cwp + 6144);
      cbv = *(const f32x4l*)(P.conv_b + n * 128 + 4 * cg); }
    LRU_LAS unsigned char* abuf = lds + L_A; LRU_LAS float* sc = (LRU_LAS float*)(lds + L_SC + wid * 2048);
    const __amdgpu_buffer_rsrc_t rU = __builtin_amdgcn_make_buffer_rsrc((void*)Ub, 0, (2047 * PITCH + 128) * 2, 0x00020000), rGt = __builtin_amdgcn_make_buffer_rsrc((void*)Gb, 0, (2047 * PITCH + 128) * 2, 0x00020000);
#define LRU_VOFF() ((lane_id_mb() >> 4) * (PITCH * 2) + (lane_id_mb() & 15) * 16 + wid * (4 * PITCH * 2))
#define LRU_DMA(rs, buf, i, vo, so) __builtin_amdgcn_raw_ptr_buffer_load_lds(rs, (LRU_LAS void*)((buf) + wid * 1024 + (i) * 8192), 16, (int)(vo), (int)(so), 0, 2  )
#define LRU_DMA_TILE(t) do { const int vo_ = LRU_VOFF(); LRU_LAS unsigned char* rb_ = lds + L_RAW + ((t) & 1) * RAWB; LRU_LAS unsigned char* gb_ = lds + L_G + ((t) & 1) * 16384; \
        const int su_ = ((t) * 64 - 3) * (PITCH * 2), sg_ = (t) * 64 * (PITCH * 2); \
        LRU_DMA(rU, rb_, 0, vo_, su_); LRU_DMA(rU, rb_, 1, vo_, su_ + 32 * PITCH * 2); if (wid == 0) { if (lane_id_mb() < 48) LRU_DMA(rU, rb_, 2, vo_, su_ + 64 * PITCH * 2); } \
        LRU_DMA(rGt, gb_, 0, vo_, sg_); LRU_DMA(rGt, gb_, 1, vo_, sg_ + 32 * PITCH * 2); } while (0)
#define LRU_BAR(N) do { asm volatile("s_waitcnt vmcnt(" #N ") lgkmcnt(0)" ::: "memory"); __builtin_amdgcn_s_barrier(); asm volatile("" ::: "memory"); } while (0)
    float hc = 0.f;
    { if (tid < 48) *(LRU_LAS u32x4*)(lds + L_RAW + tid * 16) = (u32x4){0u, 0u, 0u, 0u};
      const int vo_ = LRU_VOFF(); LRU_LAS unsigned char* rb_ = lds + L_RAW; LRU_LAS unsigned char* gb_ = lds + L_G;
      if (tid >= 48) LRU_DMA(rU, rb_, 0, vo_ - 3 * PITCH * 2, 0);
      LRU_DMA(rU, rb_, 1, vo_, 29 * PITCH * 2); if (wid == 0) { if (lane_id_mb() < 48) LRU_DMA(rU, rb_, 2, vo_, 61 * PITCH * 2); }
      LRU_DMA(rGt, gb_, 0, vo_, 0); LRU_DMA(rGt, gb_, 1, vo_, 32 * PITCH * 2); }
#define LRU_STORE_Y(tt, gb) do { const u32x4 y0 = *(const LRU_LAS u32x4*)((gb) + tid * 16), y1 = *(const LRU_LAS u32x4*)((gb) + (tid + 512) * 16); \
        *(u32x4*)(Yb + (size_t)((tt) * 64 + (tid >> 4)) * PITCH + (tid & 15) * 8) = y0; *(u32x4*)(Yb + (size_t)((tt) * 64 + 32 + (tid >> 4)) * PITCH + (tid & 15) * 8) = y1; } while (0)
    LRU_BAR(0);
    for (int t = 0; t < NT; ++t) {
        LRU_LAS unsigned char* raw = lds + L_RAW + (t & 1) * RAWB;
        LRU_LAS unsigned char* gbuf = lds + L_G + (t & 1) * 16384; LRU_LAS unsigned char* gnext = lds + L_G + ((t + 1) & 1) * 16384;
        if (t > 0) { LRU_STORE_Y(t - 1, gnext); asm volatile("s_waitcnt lgkmcnt(0)" ::: "memory"); }
        if (t + 1 < NT) LRU_DMA_TILE(t + 1);
        { u32x2 rr[7];
#pragma unroll
          for (int i = 0; i < 7; ++i) rr[i] = *(const LRU_LAS u32x2*)(raw + (4 * tt4 + i) * 256 + cg * 8);
#pragma unroll
          for (int i = 0; i < 4; ++i) { const int tk = 4 * tt4 + i;
              float v0 = cbv[0], v1 = cbv[1], v2 = cbv[2], v3 = cbv[3];
#define LRU_TAP(K, CW) do { const u32x2 x = rr[i + K]; v0 += CW[0] * bf_lo(x.x); v1 += CW[1] * bf_hi(x.x); v2 += CW[2] * bf_lo(x.y); v3 += CW[3] * bf_hi(x.y); } while (0)
              LRU_TAP(0, cw0); LRU_TAP(1, cw1); LRU_TAP(2, cw2); LRU_TAP(3, cw3);
#undef LRU_TAP
              u32x2 w; w.x = cvtpk(v0, v1); w.y = cvtpk(v2, v3);
              *(LRU_LAS u32x2*)(abuf + tk * 256 + (((cg >> 1) ^ (tk & 15)) << 4) + 8 * (cg & 1)) = w; } }
        asm volatile("s_waitcnt lgkmcnt(0)" ::: "memory"); __builtin_amdgcn_s_barrier(); asm volatile("" ::: "memory");
        f32x4l ra[4], rx[4];
#pragma unroll
        for (int blk = 0; blk < 4; ++blk) { const int row = 16 * blk + nn; ra[blk] = (f32x4l){c_ba, c_ba, c_ba, c_ba}; rx[blk] = (f32x4l){c_bx, c_bx, c_bx, c_bx};
#pragma unroll
            for (int ks = 0; ks < 4; ++ks) { const bf16x8 af = *(const LRU_LAS bf16x8*)(abuf + row * 256 + (((4 * ks + kq) ^ (row & 15)) << 4));
                ra[blk] = __builtin_amdgcn_mfma_f32_16x16x32_bf16(af, Ba[ks], ra[blk], 0, 0, 0);
                rx[blk] = __builtin_amdgcn_mfma_f32_16x16x32_bf16(af, Bx[ks], rx[blk], 0, 0, 0); } }
        typedef float f32x2l __attribute__((ext_vector_type(2)));
        float av[4][4], bv[4][4]; f32x4l sA, sB;
#pragma unroll
        for (int blk = 0; blk < 4; ++blk) { float A4 = 1.f, B4 = 0.f;
#pragma unroll
            for (int rp = 0; rp < 4; rp += 2) { const int tok0 = 16 * blk + 4 * kq + rp, tok1 = tok0 + 1;
                const unsigned short ub0 = *(const LRU_LAS unsigned short*)(abuf + tok0 * 256 + (((chl >> 3) ^ (tok0 & 15)) << 4) + (chl & 7) * 2);
                const unsigned short ub1 = *(const LRU_LAS unsigned short*)(abuf + tok1 * 256 + (((chl >> 3) ^ (tok1 & 15)) << 4) + (chl & 7) * 2);
                const f32x2l up = (f32x2l){__uint_as_float((unsigned)ub0 << 16), __uint_as_float((unsigned)ub1 << 16)};
                const f32x2l one = (f32x2l){1.0f, 1.0f};
                const f32x2l da = one + (f32x2l){__builtin_amdgcn_exp2f(ra[blk][rp]), __builtin_amdgcn_exp2f(ra[blk][rp + 1])}, di = one + (f32x2l){__builtin_amdgcn_exp2f(rx[blk][rp]), __builtin_amdgcn_exp2f(rx[blk][rp + 1])};
                const f32x2l pd = da * di; const f32x2l inv = (f32x2l){__builtin_amdgcn_rcpf(pd.x), __builtin_amdgcn_rcpf(pd.y)};
                const f32x2l r = di * inv, ig = da * inv;
                const f32x2l l2a = r * c_sp; const f32x2l a = (f32x2l){__builtin_amdgcn_exp2f(l2a.x), __builtin_amdgcn_exp2f(l2a.y)};
                const f32x2l oma = one - a, em = oma * ((f32x2l){2.0f, 2.0f} - oma);
                const f32x2l bb = (f32x2l){__builtin_amdgcn_sqrtf(em.x), __builtin_amdgcn_sqrtf(em.y)} * ig * up;
                av[blk][rp] = a.x; bv[blk][rp] = bb.x; av[blk][rp + 1] = a.y; bv[blk][rp + 1] = bb.y;
                A4 *= a.x; B4 = B4 * a.x + bb.x; A4 *= a.y; B4 = B4 * a.y + bb.y; }
            sA[blk] = A4; sB[blk] = B4; }
        *(LRU_LAS f32x4l*)(sc + (nn * 4 + kq) * 4) = sA; *(LRU_LAS f32x4l*)(sc + 256 + (nn * 4 + kq) * 4) = sB;
        __builtin_amdgcn_fence(__ATOMIC_RELEASE, "wavefront"); asm volatile("s_waitcnt lgkmcnt(0)" ::: "memory");
        f32x4l gA[4], gB[4];
#pragma unroll
        for (int q = 0; q < 4; ++q) { gA[q] = *(const LRU_LAS f32x4l*)(sc + nn * 16 + q * 4); gB[q] = *(const LRU_LAS f32x4l*)(sc + 256 + nn * 16 + q * 4); }
        float hin[4]; float h = hc;
#pragma unroll
        for (int s = 0; s < 16; ++s) { const int blk = s >> 2, q = s & 3; if (q == kq) hin[blk] = h; h = gA[q][blk] * h + gB[q][blk]; }
        hc = h;
        asm volatile("" ::: "memory");
#pragma unroll
        for (int blk = 0; blk < 4; ++blk) { float hh = hin[blk];
#pragma unroll
            for (int rg = 0; rg < 4; ++rg) { const int tok = 16 * blk + 4 * kq + rg;
                hh = av[blk][rg] * hh + bv[blk][rg];
                LRU_LAS unsigned short* gp = (LRU_LAS unsigned short*)(gbuf + tok * 256 + chl * 2);
                const float sg = __uint_as_float((unsigned)(*gp) << 16);
                *gp = (unsigned short)(cvtpk(hh * sg, 0.f) & 0xffffu); } }
        LRU_BAR(0);
    }
    LRU_STORE_Y(NT - 1, lds + L_G + ((NT - 1) & 1) * 16384);
#undef LRU_STORE_Y
#undef LRU_DMA_TILE
#undef LRU_DMA
#undef LRU_VOFF
    __syncthreads();
}
}

#define GAS __attribute__((address_space(1)))
#define LAS __attribute__((address_space(3)))
typedef unsigned short bf16;
typedef unsigned v4u __attribute__((ext_vector_type(4)));
typedef unsigned v2u __attribute__((ext_vector_type(2)));
typedef float f32x4 __attribute__((ext_vector_type(4)));
typedef short bf16x8 __attribute__((ext_vector_type(8)));
typedef GAS unsigned gu32;
typedef GAS unsigned long long gu64;
#define RLX_AGENT __ATOMIC_RELAXED, __HIP_MEMORY_SCOPE_AGENT
#define LDS_WAIT() asm volatile("s_waitcnt lgkmcnt(0)" ::: "memory")
#define VM_WAIT() asm volatile("s_waitcnt vmcnt(0)" ::: "memory")
__device__ __forceinline__ unsigned long long rt() { return __builtin_amdgcn_s_memrealtime(); }
__device__ __forceinline__ unsigned f2bf(float f) { unsigned u = __builtin_bit_cast(unsigned, f); return (u + 0x7fffu + ((u >> 16) & 1u)) >> 16; }
__device__ __forceinline__ unsigned pk2(float lo, float hi) { return f2bf(lo) | (f2bf(hi) << 16); }

#define XB_TMO      128
#define XB_XCNT(j)  (256  + 64 * (j))
#define XB_XSUB(j)  (1280 + 64 * (j))
#define XB_XGEN(j)  (2304 + 64 * (j))
#define XB_TOP      3328
#define XB_TOPGEN   3392
#define XCD_BAR_WORDS 3456
#define XB_SPIN_CAP (1u << 18)

__device__ __forceinline__ unsigned xb_ld(unsigned* p)              { return __hip_atomic_load(p, __ATOMIC_RELAXED, __HIP_MEMORY_SCOPE_AGENT); }
__device__ __forceinline__ unsigned xb_add(unsigned* p, unsigned v) { return __hip_atomic_fetch_add(p, v, __ATOMIC_RELAXED, __HIP_MEMORY_SCOPE_AGENT); }
__device__ __forceinline__ unsigned xb_xcc_id() { return (unsigned)__builtin_amdgcn_s_getreg((3 << 11) | 20) & 0xFu; }
#define XB_SPIN(cond, bar) do { unsigned _sp = 0; while (cond) { __builtin_amdgcn_s_sleep(1); \
    if ((++_sp & 255u) == 0u) { if (xb_ld(&(bar)[XB_TMO])) break; if (_sp > XB_SPIN_CAP) { atomicAdd(&(bar)[XB_TMO], 1u); break; } } } } while (0)

struct XcdBarrier {
    unsigned* bar; unsigned x;
    volatile LAS unsigned* st;
    unsigned G;
};

__device__ __forceinline__ XcdBarrier xcd_barrier_post(unsigned* bar, volatile LAS unsigned* st, bool leader, unsigned G) {
    XcdBarrier b; b.bar = bar; b.x = xb_xcc_id(); b.st = st; b.G = G;
    if (leader) (void)xb_add(&bar[XB_XCNT(b.x)], 1u);
    return b;
}
__device__ __forceinline__ void xcd_barrier_complete(unsigned* bar, unsigned x, unsigned G, unsigned& nloc, unsigned& nx) {
    unsigned sum, cnt, mine, sp = 0u;
    for (;;) {
        sum = 0u; cnt = 0u; mine = 0u;
#pragma unroll
        for (unsigned j = 0; j < 16; ++j) { const unsigned c = xb_ld(&bar[XB_XCNT(j)]); sum += c; cnt += (c > 0u) ? 1u : 0u; mine = (j == x) ? c : mine; }
        if (sum == G) break;
        __builtin_amdgcn_s_sleep(1);
        if ((++sp & 255u) == 0u) { if (xb_ld(&bar[XB_TMO])) break; if (sp > XB_SPIN_CAP) { atomicAdd(&bar[XB_TMO], 1u); break; } }
    }
    nloc = mine > 0u ? mine : 1u; nx = cnt > 0u ? cnt : 1u;
}

__device__ __forceinline__ void xcd_barrier(const XcdBarrier& b, bool leader) {
    asm volatile("s_waitcnt vmcnt(0)" ::: "memory");
    __syncthreads();
    if (leader) {
        unsigned* bar = b.bar;
        __builtin_amdgcn_s_waitcnt(0);
        unsigned nloc = b.st[0], nx = b.st[1];
        if (nloc == 0u) { xcd_barrier_complete(bar, b.x, b.G, nloc, nx); b.st[0] = nloc; b.st[1] = nx; }
        const unsigned old = xb_add(&bar[XB_XSUB(b.x)], 1u);
        const unsigned gen = old / nloc;
        if (old + 1u == (gen + 1u) * nloc) {
            if (nx > 1u) {
            __builtin_amdgcn_fence(__ATOMIC_RELEASE, "agent");
            asm volatile("s_waitcnt vmcnt(0)" ::: "memory");
            const unsigned og = xb_add(&bar[XB_TOP], 1u);
            const unsigned tg = og / nx;
            if (og + 1u == (tg + 1u) * nx) xb_add(&bar[XB_TOPGEN], 1u);
            else XB_SPIN(xb_ld(&bar[XB_TOPGEN]) == tg, bar); }
            __builtin_amdgcn_fence(__ATOMIC_ACQUIRE, "agent");
            xb_add(&bar[XB_XGEN(b.x)], 1u);
            asm volatile("s_waitcnt vmcnt(0)" ::: "memory");
        } else {
            XB_SPIN(xb_ld(&bar[XB_XGEN(b.x)]) == gen, bar);
            __builtin_amdgcn_fence(__ATOMIC_ACQUIRE, "agent");
            asm volatile("s_waitcnt vmcnt(0)" ::: "memory");
        }
    }
    __syncthreads();
}

constexpr int NWAVES = 8;
constexpr int BATCH = 16, SEQ = 2048, DM = 2048, NH = 16, HD = 128;
constexpr int M = BATCH * SEQ;
constexpr int MH = M / 8;
constexpr int N1 = 4 * DM, N3 = 2 * DM;
constexpr float LN_EPS = 1e-5f;
constexpr float DN_ALPHA = 1.4142135623730951f;
constexpr float QSCALE = 0.08838834764831845f * 1.4426950408889634f;

constexpr size_t MiB = 1u << 20;
constexpr size_t WS_CTL = 0, CTL_ZERO_BYTES = 256 * 1024;
constexpr size_t WS_W1T = 2 * MiB, WS_W2T = 34 * MiB, WS_W3T = 42 * MiB, WS_W4T = 58 * MiB;
constexpr size_t WS_R0 = 80 * MiB, WS_R1 = 208 * MiB, WS_R2 = 336 * MiB, WS_R3 = 464 * MiB, WS_R4 = 592 * MiB, WS_HC = 720 * MiB, WS_END = 752 * MiB;
constexpr int CW_TMO = 0, CW_CODE = 1, CW_BAR = 4096;
constexpr int CW_BAR_STRIDE = 4096, NGRP = 8;
static_assert((CW_BAR + (1 + NGRP) * CW_BAR_STRIDE) * 4 <= (int)CTL_ZERO_BYTES && XCD_BAR_WORDS <= CW_BAR_STRIDE, "barrier words inside the memset region");

constexpr int RING_OFF = 0, RING_BYTES = 131072;
constexpr int LDSCTL_OFF = RING_BYTES, MISC_OFF = LDSCTL_OFF + 320, TL_OFF = LDSCTL_OFF + 1024;
constexpr int LDS_BYTES = 147456;
static_assert(TL_OFF + 640 * 4 <= LDS_BYTES, "LDS map");

struct Frame {
    LAS unsigned char* lds; volatile LAS unsigned* MISC; gu32* ctl;
    int tid, lane, wave, vcu, G;
};
__device__ __forceinline__ unsigned cvt_pk(float lo, float hi) { unsigned r; asm volatile("v_cvt_pk_bf16_f32 %0, %1, %2" : "=v"(r) : "v"(lo), "v"(hi)); return r; }
__device__ __forceinline__ float wave_sum(float v) {
#pragma unroll
    for (int o = 1; o < 64; o <<= 1) v += __shfl_xor(v, o);
    return v;
}
__device__ __forceinline__ unsigned h1_corr(float h, unsigned hb_bits) {
    const unsigned e8 = (hb_bits >> 23) & 0xffu; const float inv = __uint_as_float((265u - e8) << 23);
    int q = (int)__builtin_rintf((h - __uint_as_float(hb_bits)) * inv); q = e8 < 11u ? 0 : (q > 7 ? 7 : q);
    return (unsigned)q & 0xfu; }
__device__ __forceinline__ float h1_rebuild(unsigned hb_bits, unsigned cword, int sh) {
    const unsigned e8 = (hb_bits >> 23) & 0xffu; const float step = __uint_as_float(e8 < 12u ? 0u : (e8 - 11u) << 23);
    const int q = ((int)(cword << (28 - sh))) >> 28;
    return __uint_as_float(hb_bits) + (float)q * step; }
struct P0Mat { const float* W; bf16* WT; int N; int q8; int first; };
__device__ __forceinline__ void p0_item_load(const P0Mat& m, int item, int lane, f32x4 (&r)[8]) {
    const int nblk = m.N / 32, it = item - m.first, kb = it / nblk, nb = it % nblk;
    const float* p = m.W + (size_t)(64 * kb + (lane >> 3)) * m.N + 32 * nb + 4 * (lane & 7);
#pragma unroll
    for (int i = 0; i < 8; ++i) r[i] = *(const f32x4*)(p + (size_t)(8 * i) * m.N);
}
__device__ __forceinline__ void p0_item_store(const P0Mat& m, int item, int lane, const f32x4 (&r)[8], LAS float* scr) {
    const int K = DM, nblk = m.N / 32, it = item - m.first, kb = it / nblk, nb = it % nblk, k0 = 64 * kb, n0 = 32 * nb;
#pragma unroll
    for (int i = 0; i < 8; ++i) { LAS float* d = scr + (8 * i + (lane >> 3)) * 33 + 4 * (lane & 7); d[0] = r[i].x; d[1] = r[i].y; d[2] = r[i].z; d[3] = r[i].w; }
    LDS_WAIT(); asm volatile("" ::: "memory");
    const int c = lane & 7;
#pragma unroll
    for (int j = 0; j < 4; ++j) { const int n = (lane >> 3) + 8 * j; const LAS float* s = scr + (8 * c) * 33 + n;
        float v[8];
#pragma unroll
        for (int i = 0; i < 8; ++i) v[i] = s[i * 33];
        if (m.q8) { int w0 = 0, w1 = 0;
            w0 = __builtin_amdgcn_cvt_pk_fp8_f32(v[0] * 64.f, v[1] * 64.f, w0, false); w0 = __builtin_amdgcn_cvt_pk_fp8_f32(v[2] * 64.f, v[3] * 64.f, w0, true);
            w1 = __builtin_amdgcn_cvt_pk_fp8_f32(v[4] * 64.f, v[5] * 64.f, w1, false); w1 = __builtin_amdgcn_cvt_pk_fp8_f32(v[6] * 64.f, v[7] * 64.f, w1, true);
            *(GAS v2u*)((GAS unsigned char*)m.WT + (size_t)(n0 + n) * K + k0 + 8 * c) = (v2u){(unsigned)w0, (unsigned)w1};
        } else { v4u o; o.x = cvt_pk(v[0], v[1]); o.y = cvt_pk(v[2], v[3]); o.z = cvt_pk(v[4], v[5]); o.w = cvt_pk(v[6], v[7]);
            *(GAS v4u*)(m.WT + (size_t)(n0 + n) * K + k0 + 8 * c) = o; } }
    LDS_WAIT(); asm volatile("" ::: "memory");
}

struct Args { const float* in[15]; float* out; unsigned char* ws; int ph_lo, ph_hi; };
__global__ void __launch_bounds__(NWAVES * 64, 2) hybrid_fwd(Args args) {
    extern __shared__ __attribute__((aligned(16))) unsigned char lds[];
    Frame F;
    F.lds = (LAS unsigned char*)lds;
    F.MISC = (volatile LAS unsigned*)(F.lds + MISC_OFF);
    F.wave = __builtin_amdgcn_readfirstlane((int)threadIdx.x >> 6);
    const int bx = blockIdx.x, GT = gridDim.x, GH = GT / NGRP, grp = bx & 7, lb = bx >> 3;
    F.G = GH; F.vcu = lb;
    const int rowbase = grp * MH;
    unsigned char* ws = args.ws;
    F.ctl = (gu32*)(ws + WS_CTL);
    const float* x = args.in[0]; const float* attn_w_in = args.in[1]; const float* attn_w_out = args.in[2]; const float* rel_bias = args.in[3];
    const float* lru_w_in = args.in[4]; const float* conv_w = args.in[5]; const float* conv_b = args.in[6]; const float* lru_wa = args.in[7]; const float* lru_ba = args.in[8];
    const float* lru_wx = args.in[9]; const float* lru_bx = args.in[10]; const float* lru_lam = args.in[11]; const float* lru_w_out = args.in[12];
    const float* ln_gain = args.in[13]; const float* ln_bias = args.in[14];
    float* out = args.out;
    bf16* W1t = (bf16*)(ws + WS_W1T); bf16* W2t = (bf16*)(ws + WS_W2T); bf16* W3t = (bf16*)(ws + WS_W3T); bf16* W4t = (bf16*)(ws + WS_W4T);
    unsigned char* HC = ws + WS_HC;
    bf16* R0 = (bf16*)(ws + WS_R0); bf16* R1 = (bf16*)(ws + WS_R1); bf16* R2 = (bf16*)(ws + WS_R2); bf16* R3 = (bf16*)(ws + WS_R3); bf16* R4 = (bf16*)(ws + WS_R4);

    for (int u = (F.wave * 64 + lane_id_mb()); u < (LDS_BYTES - LDSCTL_OFF) / 4; u += NWAVES * 64) ((LAS unsigned*)(F.lds + LDSCTL_OFF))[u] = 0u;
    __syncthreads();
    XcdBarrier bar_all = xcd_barrier_post((unsigned*)(F.ctl + CW_BAR), F.MISC + 8, F.wave == 0 && lane_id_mb() == 0, (unsigned)GT);
    XcdBarrier bar = xcd_barrier_post((unsigned*)(F.ctl + CW_BAR + CW_BAR_STRIDE * (1 + grp)), F.MISC + 10, F.wave == 0 && lane_id_mb() == 0, (unsigned)GH);
    const int lo = args.ph_lo, hi = args.ph_hi;
#define IN(k) (lo <= (k) && (k) < hi)
#define GRID_BAR() xcd_barrier(bar, F.wave == 0 && lane_id_mb() == 0)
    const int gw = F.vcu * NWAVES + F.wave, NGW = GH * NWAVES;

    if (IN(0)) {
        constexpr int I1 = (DM / 64) * (N1 / 32), I2 = (DM / 64) * (DM / 32), I3 = (DM / 64) * (N3 / 32), I4 = I2, NITEMS = I1 + I2 + I3 + I4;
        const P0Mat m1{attn_w_in, W1t, N1, 1, 0}, m2{attn_w_out, W2t, DM, 1, I1}, m3{lru_w_in, W3t, N3, 0, I1 + I2}, m4{lru_w_out, W4t, DM, 0, I1 + I2 + I3};
#define P0_MAT(it) ((it) < I1 ? m1 : (it) < I1 + I2 ? m2 : (it) < I1 + I2 + I3 ? m3 : m4)
        { const int ln = lane_id_mb(); LAS unsigned char* wbuf = F.lds + RING_OFF + F.wave * 16384;
          const int it0 = ((bx % 8) * (GT / 8) + bx / 8) * NWAVES + F.wave, ist = GT * NWAVES;
#define W_DMA(it_, b_) do { const P0Mat mm_ = P0_MAT(it_); const int nblk_ = mm_.N / 32, itl_ = (it_) - mm_.first, kb_ = itl_ / nblk_, nb_ = itl_ % nblk_; \
              const __amdgpu_buffer_rsrc_t rw_ = __builtin_amdgcn_make_buffer_rsrc((void*)mm_.W, 0, (int)((unsigned)mm_.N * DM * 4u), 0x00020000); \
              const unsigned so_ = ((unsigned)(64 * kb_) * mm_.N + 32u * nb_) * 4u; const int l_ = lane_id_mb(); \
              _Pragma("unroll") for (int i = 0; i < 8; ++i) __builtin_amdgcn_raw_ptr_buffer_load_lds(rw_, (LAS void*)(wbuf + (b_) * 8192 + i * 1024), 16, \
                  (int)(((unsigned)(8 * i + (l_ >> 3)) * mm_.N) * 4u + ((unsigned)((l_ & 7) ^ i) << 4)), (int)so_, 0, 0); } while (0)
          if (it0 < NITEMS) W_DMA(it0, 0);
          if (it0 + ist < NITEMS) W_DMA(it0 + ist, 1);
          v4u ob[4]; int itp = -1, k = 0;
#pragma unroll
          for (int j = 0; j < 4; ++j) ob[j] = (v4u){0u, 0u, 0u, 0u};
#define W_STORE() do { const P0Mat mp_ = P0_MAT(itp); const int nblk_ = mp_.N / 32, itl_ = itp - mp_.first, k0_ = 64 * (itl_ / nblk_), n0_ = 32 * (itl_ % nblk_), c_ = ln & 7; \
              _Pragma("unroll") for (int j = 0; j < 4; ++j) { const int n_ = (ln >> 3) + 8 * j; \
                  if (mp_.q8) *(GAS v2u*)((GAS unsigned char*)mp_.WT + (size_t)(n0_ + n_) * DM + k0_ + 8 * c_) = (v2u){ob[j].x, ob[j].y}; \
                  else *(GAS v4u*)(mp_.WT + (size_t)(n0_ + n_) * DM + k0_ + 8 * c_) = ob[j]; } } while (0)
          for (int it = it0; it < NITEMS; it += ist, k ^= 1) {
              if (it + ist < NITEMS) asm volatile("s_waitcnt vmcnt(8)" ::: "memory"); else asm volatile("s_waitcnt vmcnt(0)" ::: "memory");
              float v[4][8];
              { const int c = ln & 7;
#pragma unroll
                for (int j = 0; j < 4; ++j) { const int n = (ln >> 3) + 8 * j; const LAS unsigned char* sp = wbuf + k * 8192 + (8 * c) * 128 + (((n >> 2) ^ c) << 4) + (n & 3) * 4;
#pragma unroll
                    for (int i = 0; i < 8; ++i) v[j][i] = *(const LAS float*)(sp + i * 128); } }
              asm volatile("s_waitcnt lgkmcnt(0)" ::: "memory");
              if (itp >= 0) W_STORE();
              if (it + 2 * ist < NITEMS) W_DMA(it + 2 * ist, k);
              const bool q8 = P0_MAT(it).q8 != 0;
#pragma unroll
              for (int j = 0; j < 4; ++j) {
                  if (q8) { int w0 = 0, w1 = 0;
                      w0 = __builtin_amdgcn_cvt_pk_fp8_f32(v[j][0] * 64.f, v[j][1] * 64.f, w0, false); w0 = __builtin_amdgcn_cvt_pk_fp8_f32(v[j][2] * 64.f, v[j][3] * 64.f, w0, true);
                      w1 = __builtin_amdgcn_cvt_pk_fp8_f32(v[j][4] * 64.f, v[j][5] * 64.f, w1, false); w1 = __builtin_amdgcn_cvt_pk_fp8_f32(v[j][6] * 64.f, v[j][7] * 64.f, w1, true);
                      ob[j] = (v4u){(unsigned)w0, (unsigned)w1, 0u, 0u};
                  } else ob[j] = (v4u){cvt_pk(v[j][0], v[j][1]), cvt_pk(v[j][2], v[j][3]), cvt_pk(v[j][4], v[j][5]), cvt_pk(v[j][6], v[j][7])}; }
              itp = it; }
          if (itp >= 0) W_STORE();
#undef W_STORE
#undef W_DMA
        }
#undef P0_MAT
        { LAS unsigned char* rbuf = F.lds + RING_OFF + F.wave * 16384; const int ln = lane_id_mb();
          const __amdgpu_buffer_rsrc_t rX = __builtin_amdgcn_make_buffer_rsrc((void*)x, 0, (int)((unsigned)M * DM * 4u), 0x00020000);
#define XROW_DMA(r_, b_) do { const unsigned sx_ = (unsigned)(r_) * (DM * 4u); const int vo_ = lane_id_mb() * 16; \
              _Pragma("unroll") for (int j = 0; j < 8; ++j) __builtin_amdgcn_raw_ptr_buffer_load_lds(rX, (LAS void*)(rbuf + (b_) * 8192 + j * 1024), 16, vo_, (int)(sx_ + j * 1024u), 0, 0); } while (0)
          const int r0 = rowbase + gw, rend = rowbase + MH;
          if (r0 < rend) XROW_DMA(r0, 0);
          if (r0 + NGW < rend) XROW_DMA(r0 + NGW, 1);
          v4u qp0 = (v4u){0u, 0u, 0u, 0u}, qp1 = qp0; int rp = -1, k = 0;
          for (int r = r0; r < rend; r += NGW, k ^= 1) {
              if (r + NGW < rend) asm volatile("s_waitcnt vmcnt(8)" ::: "memory"); else asm volatile("s_waitcnt vmcnt(0)" ::: "memory");
              f32x4 v[2][4];
#pragma unroll
              for (int jj = 0; jj < 2; ++jj)
#pragma unroll
                  for (int e = 0; e < 4; ++e) v[jj][e] = *(const LAS f32x4*)(rbuf + k * 8192 + (1024 * jj + 16 * ln + 4 * e) * 4);
              asm volatile("s_waitcnt lgkmcnt(0)" ::: "memory");
              if (rp >= 0) { GAS v4u* xq = (GAS v4u*)((GAS unsigned char*)R0 + (size_t)rp * DM); xq[ln] = qp0; xq[64 + ln] = qp1; }
              if (r + 2 * NGW < rend) XROW_DMA(r + 2 * NGW, k);
#pragma unroll
              for (int jj = 0; jj < 2; ++jj) { int w[4] = {0, 0, 0, 0};
#pragma unroll
                  for (int e = 0; e < 4; ++e) { w[e] = __builtin_amdgcn_cvt_pk_fp8_f32(v[jj][e].x, v[jj][e].y, w[e], false); w[e] = __builtin_amdgcn_cvt_pk_fp8_f32(v[jj][e].z, v[jj][e].w, w[e], true); }
                  if (jj == 0) qp0 = (v4u){(unsigned)w[0], (unsigned)w[1], (unsigned)w[2], (unsigned)w[3]}; else qp1 = (v4u){(unsigned)w[0], (unsigned)w[1], (unsigned)w[2], (unsigned)w[3]}; }
              rp = r; }
          if (rp >= 0) { GAS v4u* xq = (GAS v4u*)((GAS unsigned char*)R0 + (size_t)rp * DM); xq[ln] = qp0; xq[64 + ln] = qp1; }
#undef XROW_DMA
        }
        xcd_barrier(bar_all, F.wave == 0 && lane_id_mb() == 0);
    }
    if (IN(1)) {
        pg8::Gemm g{R0 + (size_t)rowbase * (DM / 2), W1t, MH, N1, DM / 2, 0x7f7f7f7f, 0x79797979}; pg8::StaticOrder S; S.init(MH, N1, GH, lb);
        pg8::EpiBf16<0> E{R1, DM, nullptr, DM, (size_t)(WS_R2 - WS_R1) / 2, QSCALE, -1, 3, rowbase};
        pg8::gemm_phase<pg8::EpiBf16<0>, pg8::StaticOrder, true, true, true>(F.lds + RING_OFF, g, S, E, F.wave);
        GRID_BAR();
    }
    if (IN(2)) {
        const att::Tensors T{R1, R2, R3, R4, R0, rel_bias};
        for (int bh = grp * (BATCH * NH / NGRP) + F.vcu; bh < (grp + 1) * (BATCH * NH / NGRP); bh += GH) att::attn_bh(F.lds + RING_OFF, (LAS float*)(F.lds + TL_OFF), T, bh / NH, bh % NH, F.wave);
        GRID_BAR();
    }
    if (IN(3)) {
        pg8::Gemm g{R0 + (size_t)rowbase * (DM / 2), W2t, MH, DM, DM / 2, 0x79797979, 0x79797979}; pg8::StaticOrder S; S.init(MH, DM, GH, lb);
        pg8::EpiBf16<0> E{R1, DM, nullptr, 0, 0, 1.0f, -1, 0, rowbase};
        pg8::gemm_phase<pg8::EpiBf16<0>, pg8::StaticOrder, true, true, true>(F.lds + RING_OFF, g, S, E, F.wave);
        GRID_BAR();
    }
    if (IN(4)) {
        const int ln = lane_id_mb();
        f32x4 gv[8], bv[8];
#pragma unroll
        for (int j = 0; j < 8; ++j) { gv[j] = *(const f32x4*)(ln_gain + 4 * ln + 256 * j); bv[j] = *(const f32x4*)(ln_bias + 4 * ln + 256 * j); }
        LAS unsigned char* rbuf = F.lds + RING_OFF + F.wave * 16384;
        const __amdgpu_buffer_rsrc_t rX = __builtin_amdgcn_make_buffer_rsrc((void*)x, 0, (int)((unsigned)M * DM * 4u), 0x00020000), rY = __builtin_amdgcn_make_buffer_rsrc((void*)R1, 0, (int)((unsigned)M * DM * 2u), 0x00020000);
#define ROW_DMA2(r_) do { const unsigned sx_ = (unsigned)(r_) * (DM * 4u), sy_ = (unsigned)(r_) * (DM * 2u); const int vo_ = lane_id_mb() * 16; \
            _Pragma("unroll") for (int j = 0; j < 8; ++j) __builtin_amdgcn_raw_ptr_buffer_load_lds(rX, (LAS void*)(rbuf + j * 1024), 16, vo_, (int)(sx_ + j * 1024u), 0, 2  ); \
            _Pragma("unroll") for (int j = 0; j < 4; ++j) __builtin_amdgcn_raw_ptr_buffer_load_lds(rY, (LAS void*)(rbuf + 8192 + j * 1024), 16, vo_, (int)(sy_ + j * 1024u), 0, 2); } while (0)
        const int rend = rowbase + MH;
        if (rowbase + gw < rend) ROW_DMA2(rowbase + gw);
        v2u hp[8]; v4u cp; int rp = -1;
#pragma unroll
        for (int j = 0; j < 8; ++j) hp[j] = (v2u){0u, 0u};
        cp = (v4u){0u, 0u, 0u, 0u};
#define ROW_STORE2() do { GAS v2u* o4 = (GAS v2u*)(R2 + (size_t)rp * DM) + ln; _Pragma("unroll") for (int j = 0; j < 8; ++j) o4[64 * j] = hp[j]; ((GAS v4u*)(HC + (size_t)rp * (DM / 2)))[ln] = cp; } while (0)
        for (int r = rowbase + gw; r < rend; r += NGW) {
            asm volatile("s_waitcnt vmcnt(0)" ::: "memory");
            f32x4 z[8]; float s = 0.f;
            { f32x4 xv[8]; v2u yv[8];
#pragma unroll
              for (int j = 0; j < 8; ++j) { xv[j] = *(const LAS f32x4*)(rbuf + (256 * j + 4 * ln) * 4); yv[j] = *(const LAS v2u*)(rbuf + 8192 + (256 * j + 4 * ln) * 2); }
              asm volatile("s_waitcnt lgkmcnt(0)" ::: "memory");
              if (r + NGW < rend) ROW_DMA2(r + NGW);
              if (rp >= 0) ROW_STORE2();
#pragma unroll
              for (int j = 0; j < 8; ++j) {
                  z[j] = xv[j] * DN_ALPHA + (f32x4){__uint_as_float(yv[j].x << 16), __uint_as_float(yv[j].x & 0xffff0000u), __uint_as_float(yv[j].y << 16), __uint_as_float(yv[j].y & 0xffff0000u)};
                  s += (z[j].x + z[j].y) + (z[j].z + z[j].w); } }
            const float mean = wave_sum(s) * (1.0f / DM); float q = 0.f;
#pragma unroll
            for (int j = 0; j < 8; ++j) { z[j] = z[j] - mean; q += (z[j].x * z[j].x + z[j].y * z[j].y) + (z[j].z * z[j].z + z[j].w * z[j].w); }
            const float rstd = 1.0f / sqrtf(wave_sum(q) * (1.0f / DM) + LN_EPS);
            unsigned cw[4] = {0u, 0u, 0u, 0u};
#pragma unroll
            for (int j = 0; j < 8; ++j) { const f32x4 h = (z[j] * rstd) * gv[j] + bv[j]; const v2u p = (v2u){cvt_pk(h.x, h.y), cvt_pk(h.z, h.w)}; hp[j] = p;
                const unsigned hb[4] = {p.x << 16, p.x & 0xffff0000u, p.y << 16, p.y & 0xffff0000u};
#pragma unroll
                for (int e = 0; e < 4; ++e) { cw[j >> 1] |= h1_corr(h[e], hb[e]) << (16 * (j & 1) + 4 * e); } }
            cp = (v4u){cw[0], cw[1], cw[2], cw[3]}; rp = r;
        }
        if (rp >= 0) ROW_STORE2();
#undef ROW_STORE2
#undef ROW_DMA2
        GRID_BAR();
    }
    if (IN(5)) {
        pg8::Gemm g{R2 + (size_t)rowbase * DM, W3t, MH, N3, DM, 0, 0}; pg8::StaticOrder S; S.init(MH, N3, GH, lb);
        pg8::EpiBf16<0> E{R0, DM, nullptr, DM, (size_t)(WS_R4 - WS_R0) / 2, 1.0f, 1, 0, rowbase};
        pg8::gemm_phase<pg8::EpiBf16<0>, pg8::StaticOrder, true, true>(F.lds + RING_OFF, g, S, E, F.wave);
        GRID_BAR();
    }
    if (IN(6)) {
        const lru::Params P{R0, R4, R3, conv_w, conv_b, lru_wa, lru_ba, lru_wx, lru_bx, lru_lam};
        for (int bn = grp * (BATCH * 16 / NGRP) + F.vcu; bn < (grp + 1) * (BATCH * 16 / NGRP); bn += GH) lru::lru_bn(F.lds + RING_OFF, P, bn / 16, bn % 16, F.wave);
        GRID_BAR();
    }
    if (IN(7)) {
        pg8::Gemm g{R3 + (size_t)rowbase * DM, W4t, MH, DM, DM, 0, 0}; pg8::StaticOrder S; S.init(MH, DM, GH, lb);
        pg8::EpiBf16<0> E{R1, DM, nullptr, 0, 0, 1.0f, -1, 0, rowbase};
        pg8::gemm_phase<pg8::EpiBf16<0>, pg8::StaticOrder, true, true>(F.lds + RING_OFF, g, S, E, F.wave);
        GRID_BAR();
    }
    if (IN(8)) {
        unsigned bad = __hip_atomic_load(F.ctl + CW_BAR + XB_TMO, RLX_AGENT);
#pragma unroll
        for (int gi = 1; gi <= NGRP; ++gi) bad |= __hip_atomic_load(F.ctl + CW_BAR + gi * CW_BAR_STRIDE + XB_TMO, RLX_AGENT);
        const int ln = lane_id_mb();
        f32x4 g1v[8], b1v[8];
#pragma unroll
        for (int j = 0; j < 8; ++j) { g1v[j] = *(const f32x4*)(ln_gain + DM + 4 * ln + 256 * j); b1v[j] = *(const f32x4*)(ln_bias + DM + 4 * ln + 256 * j); }
        LAS unsigned char* rbuf = F.lds + RING_OFF + F.wave * 16384;
        const __amdgpu_buffer_rsrc_t rH = __builtin_amdgcn_make_buffer_rsrc((void*)R2, 0, (int)((unsigned)M * DM * 2u), 0x00020000), rW = __builtin_amdgcn_make_buffer_rsrc((void*)R1, 0, (int)((unsigned)M * DM * 2u), 0x00020000),
                                     rC = __builtin_amdgcn_make_buffer_rsrc((void*)HC, 0, (int)((unsigned)M * (DM / 2)), 0x00020000);
#define ROW_DMA3(r_) do { const unsigned sh_ = (unsigned)(r_) * (DM * 2u), sc_ = (unsigned)(r_) * (DM / 2); const int vo_ = lane_id_mb() * 16; \
            _Pragma("unroll") for (int j = 0; j < 4; ++j) __builtin_amdgcn_raw_ptr_buffer_load_lds(rH, (LAS void*)(rbuf + j * 1024), 16, vo_, (int)(sh_ + j * 1024u), 0, 2); \
            _Pragma("unroll") for (int j = 0; j < 4; ++j) __builtin_amdgcn_raw_ptr_buffer_load_lds(rW, (LAS void*)(rbuf + 4096 + j * 1024), 16, vo_, (int)(sh_ + j * 1024u), 0, 2); \
            __builtin_amdgcn_raw_ptr_buffer_load_lds(rC, (LAS void*)(rbuf + 8192), 16, vo_, (int)sc_, 0, 2); } while (0)
        const __amdgpu_buffer_rsrc_t rOut = __builtin_amdgcn_make_buffer_rsrc((void*)out, 0, (int)((unsigned)M * DM * 4u), 0x00020000);
        const int rend = rowbase + MH;
        if (rowbase + gw < rend) ROW_DMA3(rowbase + gw);
        f32x4 op[8]; int rp = -1;
#pragma unroll
        for (int j = 0; j < 8; ++j) op[j] = (f32x4){0.f, 0.f, 0.f, 0.f};
#define ROW_STORE3() do { _Pragma("unroll") for (int j = 0; j < 8; ++j) __builtin_amdgcn_raw_buffer_store_b128(__builtin_bit_cast(v4u, op[j]), rOut, ln * 16 + j * 1024, (int)((unsigned)rp * (DM * 4u)), 16  ); } while (0)
        for (int r = rowbase + gw; r < rend; r += NGW) {
            asm volatile("s_waitcnt vmcnt(0)" ::: "memory");
            f32x4 z[8]; float s = 0.f;
            { v2u hv[8], wv[8]; const v4u cn = *(const LAS v4u*)(rbuf + 8192 + ln * 16);
#pragma unroll
              for (int j = 0; j < 8; ++j) { hv[j] = *(const LAS v2u*)(rbuf + (256 * j + 4 * ln) * 2); wv[j] = *(const LAS v2u*)(rbuf + 4096 + (256 * j + 4 * ln) * 2); }
              asm volatile("s_waitcnt lgkmcnt(0)" ::: "memory");
              if (r + NGW < rend) ROW_DMA3(r + NGW);
              if (rp >= 0) ROW_STORE3();
#pragma unroll
              for (int j = 0; j < 8; ++j) { const unsigned cwd = cn[j >> 1]; const int sh = 16 * (j & 1);
                  const f32x4 h = (f32x4){h1_rebuild(hv[j].x << 16, cwd, sh), h1_rebuild(hv[j].x & 0xffff0000u, cwd, sh + 4), h1_rebuild(hv[j].y << 16, cwd, sh + 8), h1_rebuild(hv[j].y & 0xffff0000u, cwd, sh + 12)};
                  z[j] = h * DN_ALPHA + (f32x4){__uint_as_float(wv[j].x << 16), __uint_as_float(wv[j].x & 0xffff0000u), __uint_as_float(wv[j].y << 16), __uint_as_float(wv[j].y & 0xffff0000u)};
                  s += (z[j].x + z[j].y) + (z[j].z + z[j].w); } }
            const float mean = wave_sum(s) * (1.0f / DM); float q = 0.f;
#pragma unroll
            for (int j = 0; j < 8; ++j) { z[j] = z[j] - mean; q += (z[j].x * z[j].x + z[j].y * z[j].y) + (z[j].z * z[j].z + z[j].w * z[j].w); }
            float rstd = 1.0f / sqrtf(wave_sum(q) * (1.0f / DM) + LN_EPS);
            if (bad) rstd = __builtin_nanf("");
#pragma unroll
            for (int j = 0; j < 8; ++j) op[j] = (z[j] * rstd) * g1v[j] + b1v[j];
            rp = r;
        }
        if (rp >= 0) ROW_STORE3();
#undef ROW_STORE3
#undef ROW_DMA3
    }
#undef IN
#undef GRID_BAR
}

extern "C" void kernel_launch(void* const* d_in, const int* in_sizes, int n_in, void* d_out, int out_size, void* d_ws, size_t ws_size, hipStream_t stream) {
    static int grid = 0;
    if (grid == 0) {
        if (n_in != 15 || in_sizes[0] != M * DM || out_size != M * DM || ws_size < WS_END) {
            fprintf(stderr, "kernel_launch: built for 15 inputs, x/out of %d floats, >= %zu bytes of workspace; got n_in %d in0 %d out %d ws %zu\n", M * DM, (size_t)WS_END, n_in, n_in > 0 ? in_sizes[0] : -1, out_size, ws_size);
            grid = -1; return; }
        int dev = 0, cus = 0;
        if (hipGetDevice(&dev) != hipSuccess || hipDeviceGetAttribute(&cus, hipDeviceAttributeMultiprocessorCount, dev) != hipSuccess) { grid = -1; return; }
        if (hipFuncSetAttribute((const void*)hybrid_fwd, hipFuncAttributeMaxDynamicSharedMemorySize, LDS_BYTES) != hipSuccess) { fprintf(stderr, "kernel_launch: hipFuncSetAttribute failed\n"); grid = -1; return; }
        (void)hipGetLastError();
        grid = cus - cus % 8;
        if (grid != 256) fprintf(stderr, "kernel_launch: note: %d CUs (tuned for 256)\n", grid);
    }
    if (grid < 0) return;
    if (hipMemsetAsync((char*)d_ws + WS_CTL, 0, CTL_ZERO_BYTES, stream) != hipSuccess) { fprintf(stderr, "kernel_launch: hipMemsetAsync failed\n"); return; }
    Args a{};
    for (int i = 0; i < 15; ++i) a.in[i] = (const float*)d_in[i];
    a.out = (float*)d_out; a.ws = (unsigned char*)d_ws; a.ph_lo = 0; a.ph_hi = 9;
    hipLaunchKernelGGL(hybrid_fwd, dim3(grid), dim3(NWAVES * 64), LDS_BYTES, stream, a);
    const hipError_t le = hipPeekAtLastError();
    if (le != hipSuccess) fprintf(stderr, "kernel_launch: launch failed: %s\n", hipGetErrorName(le));
}
```

```cpp
#include <hip/hip_runtime.h>
#include <cstdio>
#include <cstdint>
__device__ __forceinline__ int lane_id_mb() { int l; asm volatile("v_mbcnt_lo_u32_b32 %0, -1, 0\n\tv_mbcnt_hi_u32_b32 %0, -1, %0" : "=v"(l)); return l; }
__device__ __forceinline__ int wg_tid(int wave_s) { return wave_s * 64 + lane_id_mb(); }
namespace pg8 {
#define PG8_LAS __attribute__((address_space(3)))
typedef unsigned short bf16_t;
typedef short bf16x8 __attribute__((ext_vector_type(8)));
typedef float f32x4 __attribute__((ext_vector_type(4)));
typedef unsigned u32x4 __attribute__((ext_vector_type(4)));
constexpr int BM = 256, BK = 64, HALF = 128, HTB = HALF * BK * 2  , STAGE_BYTES = 8 * HTB, NXCD = 8, WGM = 8;

__host__ __device__ __forceinline__ int lds_byte(int r, int c) { const int st = (r >> 4) * 2 + (c >> 5), rr = r & 15, cc = c & 31, ob = rr * 64 + cc * 2; return st * 1024 + (ob ^ (((ob >> 9) & 1) << 5)); }
__host__ __device__ __forceinline__ void stage_rc(int b, int& R, int& C) { const int st = b / 1024, sb = b % 1024, swz = sb ^ (((sb >> 9) & 1) << 5); R = (st >> 1) * 16 + swz / 64; C = (st & 1) * 32 + (swz % 64) / 2; }
__host__ __device__ __forceinline__ int perm32(int rho) { const int n = rho >> 4, i = rho & 15; return 8 * (i >> 2) + 4 * n + (i & 3); }

struct Unit { int pm, pn; };
struct Gemm { const bf16_t* A; const bf16_t* Bt; int M, N, K; int sA, sB; };
typedef int i32x4 __attribute__((ext_vector_type(4)));
typedef int i32x8 __attribute__((ext_vector_type(8)));
__device__ __forceinline__ i32x8 cat8(bf16x8 lo, bf16x8 hi) { return __builtin_shufflevector(__builtin_bit_cast(i32x4, lo), __builtin_bit_cast(i32x4, hi), 0, 1, 2, 3, 4, 5, 6, 7); }

struct StaticOrder {
    int nM, nN, nwg, G, c;
    __host__ __device__ void init(int M, int N, int G_, int c_) { nM = M / BM; nN = N / BM; nwg = nM * nN; G = G_; c = c_; }
    __host__ __device__ bool next(int i, Unit& u) const {
        const long L = (long)i * G + c; if (L >= nwg) return false;
        int wgid = (int)L; { const int q = nwg / NXCD, r = nwg % NXCD, xcd = wgid % NXCD, off = wgid / NXCD; wgid = (xcd < r ? xcd * (q + 1) : r * (q + 1) + (xcd - r) * q) + off; }
        const int nig = WGM * nN, gid = wgid / nig, fm = gid * WGM, gsz = (nM - fm) < WGM ? (nM - fm) : WGM;
        u.pm = fm + ((wgid % nig) % gsz); u.pn = (wgid % nig) / gsz; return true;
    }
    __device__ __forceinline__ void a_ready(const Unit&) const {}
    __device__ __forceinline__ void done(const Unit&) const {}
};

__device__ __forceinline__ unsigned cvt_pk_bf16(float lo, float hi) { unsigned r; asm volatile("v_cvt_pk_bf16_f32 %0, %1, %2" : "=v"(r) : "v"(lo), "v"(hi)); return r; }
template <int ACT  > struct EpiBf16 {
    static constexpr bool PERM = true, AFTER_DRAIN = false; static constexpr int EPI_STORES = 16  ; static_assert(ACT == 0, "EpiBf16: ACT is 0 (none)");
    bf16_t* O; int ldc; const float* bias; int split_cols; size_t split_stride; float scale0; int act_tile; int q8_tiles; int roff  ;
    __device__ __forceinline__ void operator()(const f32x4 (&acc)[2][2][4][2], const Unit& u, int wr, int wc, int fr, int fq) const {
        const int row0 = roff + u.pm * BM + wr * 64 + fr; int colt = u.pn * BM; bf16_t* base = O;
        float sc = 1.f; bool act = false, f8 = false; if (split_cols) { const int t = colt / split_cols; base += (size_t)t * split_stride; colt -= t * split_cols; if (t == 0) sc = scale0; if (t == 2 && q8_tiles > 2) sc = 8.0f; act = (t == act_tile); f8 = (t < q8_tiles); }
        const int col0 = colt + wc * 32 + 8 * fq, bcol0 = u.pn * BM + wc * 32 + 8 * fq;
        f32x4 bv[2][2];
#pragma unroll
        for (int bj = 0; bj < 2; ++bj)
#pragma unroll
            for (int n = 0; n < 2; ++n) bv[bj][n] = (f32x4){0.f, 0.f, 0.f, 0.f};
        if (f8) {
            unsigned char* b8 = (unsigned char*)base + (size_t)(row0 + ((fq & 1) ? 16 : 0)) * ldc + (col0 - ((fq & 1) ? 8 : 0));
#pragma unroll
            for (int ai = 0; ai < 2; ++ai)
#pragma unroll
                for (int bj = 0; bj < 2; ++bj)
#pragma unroll
                    for (int mp = 0; mp < 2; ++mp) { int wa0 = 0, wa1 = 0, wb0 = 0, wb1 = 0;
                        { const f32x4 v0 = acc[ai][bj][2 * mp][0] * sc, v1 = acc[ai][bj][2 * mp][1] * sc;
                          wa0 = __builtin_amdgcn_cvt_pk_fp8_f32(v0[0], v0[1], wa0, false); wa0 = __builtin_amdgcn_cvt_pk_fp8_f32(v0[2], v0[3], wa0, true);
                          wa1 = __builtin_amdgcn_cvt_pk_fp8_f32(v1[0], v1[1], wa1, false); wa1 = __builtin_amdgcn_cvt_pk_fp8_f32(v1[2], v1[3], wa1, true); }
                        { const f32x4 v0 = acc[ai][bj][2 * mp + 1][0] * sc, v1 = acc[ai][bj][2 * mp + 1][1] * sc;
                          wb0 = __builtin_amdgcn_cvt_pk_fp8_f32(v0[0], v0[1], wb0, false); wb0 = __builtin_amdgcn_cvt_pk_fp8_f32(v0[2], v0[3], wb0, true);
                          wb1 = __builtin_amdgcn_cvt_pk_fp8_f32(v1[0], v1[1], wb1, false); wb1 = __builtin_amdgcn_cvt_pk_fp8_f32(v1[2], v1[3], wb1, true); }
                        const auto r0 = __builtin_amdgcn_permlane16_swap((unsigned)wa0, (unsigned)wb0, false, false), r1 = __builtin_amdgcn_permlane16_swap((unsigned)wa1, (unsigned)wb1, false, false);
                        *(u32x4*)(b8 + (size_t)(ai * HALF + 32 * mp) * ldc + bj * HALF) = (u32x4){r0[0], r1[0], r0[1], r1[1]}; }
            return; }
#pragma unroll
        for (int ai = 0; ai < 2; ++ai)
#pragma unroll
            for (int m = 0; m < 4; ++m) { bf16_t* rowp = base + (size_t)(row0 + ai * HALF + m * 16) * ldc + col0;
#pragma unroll
                for (int bj = 0; bj < 2; ++bj) { f32x4 v0 = acc[ai][bj][m][0] + bv[bj][0], v1 = acc[ai][bj][m][1] + bv[bj][1];
                    if (act) {
#pragma unroll
                        for (int j = 0; j < 4; ++j) { v0[j] = v0[j] * __builtin_amdgcn_rcpf(1.0f + __builtin_amdgcn_exp2f(-1.4426950408889634f * v0[j])); v1[j] = v1[j] * __builtin_amdgcn_rcpf(1.0f + __builtin_amdgcn_exp2f(-1.4426950408889634f * v1[j])); } }
                    v0 = v0 * sc; v1 = v1 * sc;
                    if (f8) { int w0 = 0, w1 = 0;
                        w0 = __builtin_amdgcn_cvt_pk_fp8_f32(v0[0], v0[1], w0, false); w0 = __builtin_amdgcn_cvt_pk_fp8_f32(v0[2], v0[3], w0, true);
                        w1 = __builtin_amdgcn_cvt_pk_fp8_f32(v1[0], v1[1], w1, false); w1 = __builtin_amdgcn_cvt_pk_fp8_f32(v1[2], v1[3], w1, true);
                        typedef unsigned u32x2e __attribute__((ext_vector_type(2)));
                        *(u32x2e*)((unsigned char*)base + (size_t)(row0 + ai * HALF + m * 16) * ldc + col0 + bj * HALF) = (u32x2e){(unsigned)w0, (unsigned)w1};
                    } else { u32x4 w; w.x = cvt_pk_bf16(v0[0], v0[1]); w.y = cvt_pk_bf16(v0[2], v0[3]); w.z = cvt_pk_bf16(v1[0], v1[1]); w.w = cvt_pk_bf16(v1[2], v1[3]);
                        *(u32x4*)(rowp + bj * HALF) = w; } } }
    }
};
template <class Epi, class Sched, bool ALIGN_EPI = false, bool SP2 = false, bool FP8 = false>
__device__ __forceinline__ void gemm_phase(PG8_LAS unsigned char* lds, const Gemm g, const Sched& S, const Epi& E, int wv) {
    int tid_ = wg_tid(wv); asm volatile("" : "+v"(tid_));
    const int tid = tid_, wid = __builtin_amdgcn_readfirstlane(tid >> 6), lane = tid & 63, wr = wid >> 2, wc = wid & 3, fr = lane & 15, fq = lane >> 4;
    const int K = g.K, nt = K / BK;
    unsigned voffA[2], voffB[2];
#pragma unroll
    for (int i = 0; i < 2; ++i) { int R, C; stage_rc(tid * 16 + i * 8192, R, C); const int Rb = Epi::PERM ? ((R & ~31) + perm32(R & 31)) : R;
        voffA[i] = (unsigned)(R * K + C) * 2u; voffB[i] = (unsigned)(Rb * K + C) * 2u; }
    const unsigned rstep64 = 64u * (unsigned)K * 2u;
    const unsigned kstep = (unsigned)(BK * 2);
    const unsigned hstep = (unsigned)HALF * K * 2;
    const unsigned tstep = 2 * hstep;
    const unsigned ldsw = (unsigned)wid * 1024u;
    const int aoff = lds_byte(wr * 64 + fr, fq * 8), boff = lds_byte(wc * 32 + fr, fq * 8);
#define PG8_SA(b, h) (((b) * 2 + (h)) * HTB)
#define PG8_SB(b, h) ((4 + (b) * 2 + (h)) * HTB)
#define PG8_STAGE(bufoff, goff, voff) do { _Pragma("unroll") for (int _i = 0; _i < 2; ++_i) \
        __builtin_amdgcn_raw_ptr_buffer_load_lds((&(voff)[0] == &voffA[0]) ? rA : rB, (PG8_LAS void*)(lds + (bufoff) + ldsw + _i * 8192), 16, (int)(voff)[0], (int)((goff) + (unsigned)_i * rstep64), 0, 0); } while (0)
#define PG8_LDA(dst, b, h) do { _Pragma("unroll") for (int m = 0; m < 4; ++m) { if constexpr (FP8) dst##8[m] = cat8(*(const PG8_LAS bf16x8*)(lds + PG8_SA(b, h) + aoff + m * 2048), *(const PG8_LAS bf16x8*)(lds + PG8_SA(b, h) + aoff + m * 2048 + 1024)); \
        else { _Pragma("unroll") for (int k = 0; k < 2; ++k) dst[m][k] = *(const PG8_LAS bf16x8*)(lds + PG8_SA(b, h) + aoff + m * 2048 + k * 1024); } } } while (0)
#define PG8_LDB(dst, b, h) do { _Pragma("unroll") for (int n = 0; n < 2; ++n) { if constexpr (FP8) dst##8[n] = cat8(*(const PG8_LAS bf16x8*)(lds + PG8_SB(b, h) + boff + n * 2048), *(const PG8_LAS bf16x8*)(lds + PG8_SB(b, h) + boff + n * 2048 + 1024)); \
        else { _Pragma("unroll") for (int k = 0; k < 2; ++k) dst[n][k] = *(const PG8_LAS bf16x8*)(lds + PG8_SB(b, h) + boff + n * 2048 + k * 1024); } } } while (0)
#define PG8_MMA(ai, bj, At, Bt) do { __builtin_amdgcn_s_setprio(1); _Pragma("unroll") for (int m = 0; m < 4; ++m) _Pragma("unroll") for (int n = 0; n < 2; ++n) { \
        if constexpr (FP8) acc[ai][bj][m][n] = __builtin_amdgcn_mfma_scale_f32_16x16x128_f8f6f4(Bt##8[n], At##8[m], acc[ai][bj][m][n], 0, 0, 0, g.sB, 0, g.sA); \
        else { _Pragma("unroll") for (int k = 0; k < 2; ++k) acc[ai][bj][m][n] = __builtin_amdgcn_mfma_f32_16x16x32_bf16(Bt[n][k], At[m][k], acc[ai][bj][m][n], 0, 0, 0); } } __builtin_amdgcn_s_setprio(0); } while (0)
#define PG8_WAIT_V(n) asm volatile("s_waitcnt vmcnt(" #n ")" ::: "memory")
#define PG8_WAIT_L(n) asm volatile("s_waitcnt lgkmcnt(" #n ")" ::: "memory")
#define PG8_BAR __builtin_amdgcn_s_barrier()
#define PG8_SCHED __builtin_amdgcn_sched_barrier(0)
    Unit cur, nxt; int ui = 0;
    if (!S.next(0, cur)) return;
    f32x4 acc[2][2][4][2];
#pragma unroll
    for (int a = 0; a < 2; ++a)
#pragma unroll
        for (int b = 0; b < 2; ++b)
#pragma unroll
            for (int m = 0; m < 4; ++m)
#pragma unroll
                for (int n = 0; n < 2; ++n) acc[a][b][m][n] = (f32x4){0.f, 0.f, 0.f, 0.f};
    bf16x8 At[4][2], B0[2][2], B1[2][2]; i32x8 At8[4], B08[2], B18[2];
    const __amdgpu_buffer_rsrc_t rA = __builtin_amdgcn_make_buffer_rsrc((void*)g.A, 0, (int)((unsigned)g.M * (unsigned)K * 2u), 0x00020000), rB = __builtin_amdgcn_make_buffer_rsrc((void*)g.Bt, 0, (int)((unsigned)g.N * (unsigned)K * 2u), 0x00020000);
    unsigned cA = (unsigned)cur.pm * tstep, cB = (unsigned)cur.pn * tstep;
    S.a_ready(cur);
    if constexpr (SP2) {
        PG8_STAGE(PG8_SB(0, 0), cB, voffB); PG8_STAGE(PG8_SB(0, 1), cB + hstep, voffB); PG8_STAGE(PG8_SA(0, 0), cA, voffA); PG8_STAGE(PG8_SA(0, 1), cA + hstep, voffA);
        if (wr == 1) PG8_BAR;
        PG8_WAIT_V(2); PG8_BAR;
        PG8_STAGE(PG8_SB(1, 0), cB + kstep, voffB); PG8_STAGE(PG8_SA(1, 0), cA + kstep, voffA); PG8_STAGE(PG8_SB(1, 1), cB + hstep + kstep, voffB);
        PG8_WAIT_V(6); PG8_BAR;
    } else {
        PG8_STAGE(PG8_SB(0, 0), cB, voffB); PG8_STAGE(PG8_SA(0, 0), cA, voffA); PG8_STAGE(PG8_SB(0, 1), cB + hstep, voffB); PG8_STAGE(PG8_SA(0, 1), cA + hstep, voffA);
        if (wr == 1) PG8_BAR;
        PG8_WAIT_V(4); PG8_BAR;
        PG8_STAGE(PG8_SB(1, 0), cB + kstep, voffB); PG8_STAGE(PG8_SA(1, 0), cA + kstep, voffA); PG8_STAGE(PG8_SB(1, 1), cB + hstep + kstep, voffB);
        PG8_WAIT_V(6); PG8_BAR;
    }
    for (;;) {
        const bool has_next = S.next(ui + 1, nxt);
        const unsigned nA = has_next ? (unsigned)nxt.pm * tstep : cA, nB = has_next ? (unsigned)nxt.pn * tstep : cB;
        for (int t = 0; t < nt; t += 2) {
            const bool last = (t == nt - 2);
            const unsigned a1 = cA + (unsigned)(t + 1) * kstep;
            const unsigned a2 = last ? nA : cA + (unsigned)(t + 2) * kstep, b2 = last ? nB : cB + (unsigned)(t + 2) * kstep;
            const unsigned a3 = a2 + kstep, b3 = b2 + kstep;
            if (last && has_next) S.a_ready(nxt);
            if constexpr (SP2) {
            PG8_LDB(B0, 0, 0); PG8_LDB(B1, 0, 1); PG8_SCHED; PG8_LDA(At, 0, 0); PG8_STAGE(PG8_SA(1, 1), a1 + hstep, voffA);
            PG8_WAIT_V(8);
            PG8_WAIT_L(0); PG8_BAR; PG8_MMA(0, 0, At, B0); PG8_MMA(0, 1, At, B1); PG8_BAR; PG8_SCHED;
            PG8_LDA(At, 0, 1); PG8_STAGE(PG8_SB(0, 0), b2, voffB); PG8_STAGE(PG8_SB(0, 1), b2 + hstep, voffB); PG8_STAGE(PG8_SA(0, 0), a2, voffA);
            PG8_WAIT_V(8);
            PG8_WAIT_L(0); PG8_BAR; PG8_MMA(1, 0, At, B0); PG8_MMA(1, 1, At, B1); PG8_BAR; PG8_SCHED;
            PG8_LDB(B0, 1, 0); PG8_LDB(B1, 1, 1); PG8_SCHED; PG8_LDA(At, 1, 0); PG8_STAGE(PG8_SA(0, 1), a2 + hstep, voffA);
            PG8_WAIT_V(8); PG8_WAIT_L(0); PG8_BAR; PG8_MMA(0, 0, At, B0); PG8_MMA(0, 1, At, B1); PG8_BAR; PG8_SCHED;
            PG8_LDA(At, 1, 1); PG8_STAGE(PG8_SB(1, 0), b3, voffB); PG8_STAGE(PG8_SB(1, 1), b3 + hstep, voffB); PG8_STAGE(PG8_SA(1, 0), a3, voffA);
            PG8_WAIT_V(8); PG8_WAIT_L(0); PG8_BAR; PG8_MMA(1, 0, At, B0); PG8_MMA(1, 1, At, B1); PG8_BAR; PG8_SCHED;
            } else {
            PG8_LDB(B0, 0, 0); PG8_SCHED; PG8_LDA(At, 0, 0); PG8_STAGE(PG8_SA(1, 1), a1 + hstep, voffA);
            PG8_WAIT_L(8); PG8_BAR; PG8_WAIT_L(0); PG8_MMA(0, 0, At, B0); PG8_BAR; PG8_SCHED;
            PG8_LDB(B1, 0, 1); PG8_STAGE(PG8_SB(0, 0), b2, voffB);
            PG8_BAR; PG8_WAIT_L(0); PG8_MMA(0, 1, At, B1); PG8_BAR;
            PG8_LDA(At, 0, 1); PG8_STAGE(PG8_SA(0, 0), a2, voffA);
            PG8_BAR; PG8_WAIT_L(0); PG8_MMA(1, 0, At, B0); PG8_BAR; PG8_SCHED;
            PG8_STAGE(PG8_SB(0, 1), b2 + hstep, voffB);
            PG8_WAIT_V(6); PG8_BAR; PG8_MMA(1, 1, At, B1); PG8_BAR;
            PG8_LDB(B0, 1, 0); PG8_SCHED; PG8_LDA(At, 1, 0); PG8_STAGE(PG8_SA(0, 1), a2 + hstep, voffA);
            PG8_WAIT_L(8); PG8_BAR; PG8_WAIT_L(0); PG8_MMA(0, 0, At, B0); PG8_BAR; PG8_SCHED;
            PG8_LDB(B1, 1, 1); PG8_STAGE(PG8_SB(1, 0), b3, voffB);
            PG8_BAR; PG8_WAIT_L(0); PG8_MMA(0, 1, At, B1); PG8_BAR;
            PG8_LDA(At, 1, 1); PG8_STAGE(PG8_SA(1, 0), a3, voffA);
            PG8_BAR; PG8_WAIT_L(0); PG8_MMA(1, 0, At, B0); PG8_BAR; PG8_SCHED;
            PG8_STAGE(PG8_SB(1, 1), b3 + hstep, voffB);
            PG8_WAIT_V(6); PG8_BAR; PG8_MMA(1, 1, At, B1); PG8_BAR;
            }
        }
        if constexpr (ALIGN_EPI) { if (wr == 0) PG8_BAR; }
        if constexpr (!Epi::AFTER_DRAIN) { const int ln_ = lane_id_mb(); E(acc, cur, wr, wc, ln_ & 15, ln_ >> 4); S.done(cur); }
        if (!has_next) break;
#pragma unroll
        for (int a = 0; a < 2; ++a)
#pragma unroll
            for (int b = 0; b < 2; ++b)
#pragma unroll
                for (int m = 0; m < 4; ++m)
#pragma unroll
                    for (int n = 0; n < 2; ++n) acc[a][b][m][n] = (f32x4){0.f, 0.f, 0.f, 0.f};
        cur = nxt; cA = nA; cB = nB; ++ui;
        if constexpr (ALIGN_EPI) { if (wr == 1) PG8_BAR; }
    }
    PG8_WAIT_V(0);
    if constexpr (!ALIGN_EPI) { if (wr == 0) PG8_BAR; }
    PG8_BAR;
    if constexpr (Epi::AFTER_DRAIN) { E.fused(acc, cur, wr, wc, fr, fq, lds, wid, lane); S.done(cur); }
#undef PG8_SA
#undef PG8_SB
#undef PG8_STAGE
#undef PG8_LDA
#undef PG8_LDB
#undef PG8_MMA
#undef PG8_WAIT_V
#undef PG8_WAIT_L
#undef PG8_BAR
#undef PG8_SCHED
}
}

namespace att {
typedef short bf16x8 __attribute__((ext_vector_type(8)));
typedef short s16x4 __attribute__((ext_vector_type(4)));
typedef float f32x16 __attribute__((ext_vector_type(16)));
typedef float f32x4a __attribute__((ext_vector_type(4)));
typedef unsigned u32x4 __attribute__((ext_vector_type(4)));
typedef unsigned u32x2 __attribute__((ext_vector_type(2)));
#define ATT_LAS __attribute__((address_space(3)))
constexpr int SEQ = 2048, PITCH = 2048, NQG = 8;
typedef int i32x8a __attribute__((ext_vector_type(8)));
__device__ __forceinline__ i32x8a cat4(long a, long b, long c, long d) { return (i32x8a){(int)a, (int)(a >> 32), (int)b, (int)(b >> 32), (int)c, (int)(c >> 32), (int)d, (int)(d >> 32)}; }
constexpr int KVB = 16384;
constexpr int KB8 = 8192;
constexpr int LDS_V = 0, LDS_K = 8 * KB8;
constexpr int STG_STRIDE = 272, STG_WAVE = 32 * STG_STRIDE;
constexpr int TL_N = 640;
constexpr float THR = 6.0f;
__device__ __forceinline__ unsigned cvtpk(float lo, float hi) { unsigned r; asm volatile("v_cvt_pk_bf16_f32 %0, %1, %2" : "=v"(r) : "v"(lo), "v"(hi)); return r; }
__device__ __forceinline__ int kswz(int row, int colB) { return row * 256 + (colB ^ ((row & 7) << 4)); }
__device__ __forceinline__ int v_st(int k, int c) { return ((k >> 3) * 4 + (c >> 5)) * 512 + ((k & 7) * 32 + (c & 31)) * 2; }
__device__ __forceinline__ int v_rd_base(int lane) { return ((lane & 3) << 3) | (((lane >> 2) & 3) << 6) | (((lane >> 4) & 1) << 5) | (((lane >> 5) & 1) << 8); }
typedef short v4i16_t __attribute__((ext_vector_type(4)));
__device__ __forceinline__ s16x4 vtr(const ATT_LAS char* p) { return __builtin_bit_cast(s16x4, __builtin_amdgcn_ds_read_tr16_b64_v4i16((ATT_LAS v4i16_t*)p)); }
#define ATT_PK(L, H) (bf16x8){L[0], L[1], L[2], L[3], H[0], H[1], H[2], H[3]}
template <int OFF> __device__ __forceinline__ s16x4 tr_read(int vb) { s16x4 r; asm volatile("ds_read_b64_tr_b16 %0, %1 offset:%2" : "=&v"(r) : "v"(vb), "i"(OFF) : "memory"); return r; }
template <int D0> __device__ __forceinline__ void pv_one(f32x16& od, int vb, bf16x8 pb0, bf16x8 pb1, bf16x8 pb2, bf16x8 pb3) {
    const s16x4 l0 = tr_read<D0 * 512 + 0 * 4096>(vb), h0 = tr_read<D0 * 512 + 0 * 4096 + 2048>(vb), l1 = tr_read<D0 * 512 + 1 * 4096>(vb), h1 = tr_read<D0 * 512 + 1 * 4096 + 2048>(vb);
    const s16x4 l2 = tr_read<D0 * 512 + 2 * 4096>(vb), h2 = tr_read<D0 * 512 + 2 * 4096 + 2048>(vb), l3 = tr_read<D0 * 512 + 3 * 4096>(vb), h3 = tr_read<D0 * 512 + 3 * 4096 + 2048>(vb);
    asm volatile("s_waitcnt lgkmcnt(0)" ::: "memory"); __builtin_amdgcn_sched_barrier(0);
    od = __builtin_amdgcn_mfma_f32_32x32x16_bf16(ATT_PK(l0, h0), pb0, od, 0, 0, 0);
    od = __builtin_amdgcn_mfma_f32_32x32x16_bf16(ATT_PK(l1, h1), pb1, od, 0, 0, 0);
    od = __builtin_amdgcn_mfma_f32_32x32x16_bf16(ATT_PK(l2, h2), pb2, od, 0, 0, 0);
    od = __builtin_amdgcn_mfma_f32_32x32x16_bf16(ATT_PK(l3, h3), pb3, od, 0, 0, 0);
}
struct Tensors { const unsigned short* Q; const unsigned short* K; const unsigned short* V; const unsigned short* G; unsigned short* O; const float* table; };

__device__ __forceinline__ void attn_bh(ATT_LAS unsigned char* lds, ATT_LAS float* tl, const Tensors& T, int b, int h, int wv) {
    int tid_ = wg_tid(wv); asm volatile("" : "+v"(tid_));
    const int tid = tid_, lane = tid & 63, r32 = lane & 31, hi = lane >> 5; const int wid = __builtin_amdgcn_readfirstlane(tid >> 6);
    for (int e = tid; e < TL_N; e += 512) { int d = 575 - e; d = d > 256 ? 256 : d; d = d < -256 ? -256 : d; tl[e] = T.table[h * 513 + d + 256] * 1.4426950408889634f; }
    const int ci = wid < 4 ? wid : 7 - wid, hf = wid >> 2;
    const size_t rowb = (size_t)b * SEQ;
    const unsigned hbase = (unsigned)(rowb * PITCH + h * 128) * 2u;
    const __amdgpu_buffer_rsrc_t rK = __builtin_amdgcn_make_buffer_rsrc((void*)T.K, 0, (int)(32768u * PITCH), 0x00020000), rV = __builtin_amdgcn_make_buffer_rsrc((void*)T.V, 0, (int)(32768u * PITCH), 0x00020000);
    unsigned koff0, koff1, voff0, voff1;
    { const int l16 = lane & 15, rq = lane >> 4;
      { const int row = 8 * wid + (lane >> 3); koff0 = (unsigned)(row * PITCH + (((lane & 7) ^ ((row >> 1) & 7)) << 4)); koff1 = 0u; (void)l16; (void)rq; }
      { const int row = 8 * wid + (lane >> 3), c16 = lane & 7, fv = ((row >> 1) & 1) | (((row >> 3) & 1) << 1);
        voff0 = (unsigned)(row * PITCH + (((c16 & 1) | (((c16 >> 1) ^ fv) << 1)) << 4)); voff1 = 0u; } }
    int vbase8[4];
    { const int g_ = lane >> 4, i_ = lane & 15; const int q_ = i_ >> 1, p_ = i_ & 1; const int h_ = g_ >> 1, kr0 = q_ < 4 ? 4 * h_ + q_ : 8 + 4 * h_ + (q_ - 4), fv = ((kr0 >> 1) & 1) | (((kr0 >> 3) & 1) << 1);
#pragma unroll
      for (int d0 = 0; d0 < 4; ++d0) { vbase8[d0] = (int)(unsigned)(uintptr_t)(lds + LDS_V) + kr0 * 128 + ((d0 ^ fv) << 5) + 16 * (g_ & 1) + 8 * p_; asm volatile("" : "+v"(vbase8[d0])); } }
    int kbase[8];
#pragma unroll
    for (int j = 0; j < 8; ++j) { kbase[j] = r32 * 128 + ((j ^ ((r32 >> 1) & 7)) << 4) + 8 * hi; asm volatile("" : "+v"(kbase[j])); }
#define ATT_DMA(t, slot) do { const int so_ = (int)(hbase + (unsigned)(t) * (64u * PITCH * 2u)); \
        __builtin_amdgcn_raw_ptr_buffer_load_lds(rK, (ATT_LAS void*)(lds + LDS_K + (slot) * KB8 + 1024 * wid), 16, (int)koff0, (int)((unsigned)so_ >> 1), 0, 0); \
        __builtin_amdgcn_raw_ptr_buffer_load_lds(rV, (ATT_LAS void*)(lds + LDS_V + (slot) * KB8 + 1024 * wid), 16, (int)voff0, (int)((unsigned)so_ >> 1), 0, 0); } while (0)
#define ATT_BAR(N) do { asm volatile("s_waitcnt vmcnt(" #N ") lgkmcnt(0)" ::: "memory"); __builtin_amdgcn_s_barrier(); asm volatile("" ::: "memory"); } while (0)
    ATT_BAR(0);
    long qr[8];
#define ATT_QLOAD(qw0_) do { const unsigned char* Qw = (const unsigned char*)T.Q + (rowb + (qw0_) + r32) * PITCH + h * 128 + hi * 8; \
        _Pragma("unroll") for (int d0 = 0; d0 < 8; ++d0) qr[d0] = *(const long*)(Qw + d0 * 16); } while (0)
    ATT_QLOAD(ci * 64 + hf * 32); ATT_DMA(0, 0); ATT_DMA(1, 1); ATT_DMA(2, 2); ATT_DMA(3, 3);
#pragma unroll
    for (int d0 = 0; d0 < 8; ++d0) asm volatile("" : "+v"(qr[d0]));
    ATT_BAR(0);
    for (int qg = 0; qg < NQG; ++qg) {
        const int c0 = 4 * qg, t_lo = c0 - 8 > 0 ? c0 - 8 : 0, t_hi = c0 + 3;
        const int c = c0 + ci, my_lo = c - 8 > 0 ? c - 8 : 0, my_hi = c;
        const int qw0 = c * 64 + hf * 32;
        float m_reg = -1e30f, l_reg = 0.f; f32x16 o[4];
#pragma unroll
        for (int d = 0; d < 4; ++d)
#pragma unroll
            for (int r = 0; r < 16; ++r) o[d][r] = 0.f;
        const int D = c0 >= 8 ? 3 : 0, nsteps = (c0 + 3 < 8 ? c0 + 3 : 8) + 1, rmax = t_hi - t_lo;
        int next_r = 4;
        for (int jp = 0; jp < nsteps; jp += (jp == 0 ? 1 : 2)) {
            const int cnt = jp == 0 ? 1 : 2;
            for (; next_r <= rmax && next_r <= jp + 7; ++next_r) ATT_DMA(t_lo + next_r, next_r & 7);
          for (int u = 0; u < cnt; ++u) { const int j = jp + u; if (j >= nsteps) break; const int t = my_lo + j, slot = (t - t_lo) & 7;
            if (t >= my_lo && t <= my_hi) {
                const ATT_LAS float* tb = tl + (575 - (qw0 - t * 64) - r32 + 4 * hi);
                f32x16 p0, p1;
#pragma unroll
                for (int r = 0; r < 16; ++r) { p0[r] = tb[(r & 3) + 8 * (r >> 2)]; p1[r] = tb[32 + (r & 3) + 8 * (r >> 2)]; }
                const int kbo = slot * KB8;
                long kf0[8], kf1[8];
#pragma unroll
                for (int d0 = 0; d0 < 8; ++d0) { const ATT_LAS char* kp_ = (const ATT_LAS char*)lds + LDS_K + kbase[d0] + kbo;
                    kf0[d0] = *(const ATT_LAS long*)(kp_); kf1[d0] = *(const ATT_LAS long*)(kp_ + 4096); }
                __builtin_amdgcn_sched_barrier(0);
#pragma unroll
                for (int s = 0; s < 2; ++s) { const i32x8a qq = cat4(qr[4 * s], qr[4 * s + 1], qr[4 * s + 2], qr[4 * s + 3]);
                    p0 = __builtin_amdgcn_mfma_scale_f32_32x32x64_f8f6f4(cat4(kf0[4 * s], kf0[4 * s + 1], kf0[4 * s + 2], kf0[4 * s + 3]), qq, p0, 0, 0, 0, 0x7f7f7f7f, 0, 0x7f7f7f7f);
                    p1 = __builtin_amdgcn_mfma_scale_f32_32x32x64_f8f6f4(cat4(kf1[4 * s], kf1[4 * s + 1], kf1[4 * s + 2], kf1[4 * s + 3]), qq, p1, 0, 0, 0, 0x7f7f7f7f, 0, 0x7f7f7f7f); }
                __builtin_amdgcn_sched_barrier(0);
                float pmax = p0[0];
#pragma unroll
                for (int r = 1; r < 16; ++r) pmax = fmaxf(pmax, p0[r]);
#pragma unroll
                for (int r = 0; r < 16; ++r) pmax = fmaxf(pmax, p1[r]);
                { auto rr = __builtin_amdgcn_permlane32_swap(__float_as_uint(pmax), __float_as_uint(pmax), false, false); pmax = fmaxf(__uint_as_float(rr[0]), __uint_as_float(rr[1])); }
                if (!__all(pmax - m_reg <= THR)) {
                    const float mn = fmaxf(m_reg, pmax), alpha = __builtin_amdgcn_exp2f(m_reg - mn); m_reg = mn; l_reg *= alpha;
#pragma unroll
                    for (int d = 0; d < 4; ++d)
#pragma unroll
                        for (int r = 0; r < 16; ++r) o[d][r] *= alpha;
                }
                float ps0 = 0.f, ps1 = 0.f, ps2 = 0.f, ps3 = 0.f;
#pragma unroll
                for (int r = 0; r < 16; r += 4) { p0[r] = __builtin_amdgcn_exp2f(p0[r] - m_reg); ps0 += p0[r]; p0[r + 1] = __builtin_amdgcn_exp2f(p0[r + 1] - m_reg); ps1 += p0[r + 1];
                    p0[r + 2] = __builtin_amdgcn_exp2f(p0[r + 2] - m_reg); ps2 += p0[r + 2]; p0[r + 3] = __builtin_amdgcn_exp2f(p0[r + 3] - m_reg); ps3 += p0[r + 3]; }
#pragma unroll
                for (int r = 0; r < 16; r += 4) { p1[r] = __builtin_amdgcn_exp2f(p1[r] - m_reg); ps0 += p1[r]; p1[r + 1] = __builtin_amdgcn_exp2f(p1[r + 1] - m_reg); ps1 += p1[r + 1];
                    p1[r + 2] = __builtin_amdgcn_exp2f(p1[r + 2] - m_reg); ps2 += p1[r + 2]; p1[r + 3] = __builtin_amdgcn_exp2f(p1[r + 3] - m_reg); ps3 += p1[r + 3]; }
                l_reg += (ps0 + ps1) + (ps2 + ps3);
                long pb8[4];
#define ATT_PK8(P, B0) ({ int lo_ = 0, hi_ = 0; lo_ = __builtin_amdgcn_cvt_pk_fp8_f32(P[B0], P[B0 + 1], lo_, false); lo_ = __builtin_amdgcn_cvt_pk_fp8_f32(P[B0 + 2], P[B0 + 3], lo_, true); \
                    hi_ = __builtin_amdgcn_cvt_pk_fp8_f32(P[B0 + 4], P[B0 + 5], hi_, false); hi_ = __builtin_amdgcn_cvt_pk_fp8_f32(P[B0 + 6], P[B0 + 7], hi_, true); (long)(((unsigned long long)(unsigned)hi_ << 32) | (unsigned)lo_); })
                pb8[0] = ATT_PK8(p0, 0); pb8[1] = ATT_PK8(p0, 8); pb8[2] = ATT_PK8(p1, 0); pb8[3] = ATT_PK8(p1, 8);
#undef ATT_PK8
                const int vso = slot * KB8;
#pragma unroll
                for (int d0 = 0; d0 < 4; ++d0) { long vf[4];
#pragma unroll
                    for (int ks = 0; ks < 4; ++ks) asm volatile("ds_read_b64_tr_b8 %0, %1 offset:%2" : "=&v"(vf[ks]) : "v"(vbase8[d0] + vso), "i"(ks * 2048) : "memory");
                    asm volatile("s_waitcnt lgkmcnt(0)" ::: "memory"); __builtin_amdgcn_sched_barrier(0);
                    o[d0] = __builtin_amdgcn_mfma_scale_f32_32x32x64_f8f6f4(cat4(vf[0], vf[1], vf[2], vf[3]), cat4(pb8[0], pb8[1], pb8[2], pb8[3]), o[d0], 0, 0, 0, 0x7f7f7f7f, 0, 0x7f7f7f7f); }
            }
          }
            { const int jn = jp + cnt, need = jn + 1 + D < rmax ? jn + 1 + D : rmax; const int n = (next_r - 1) - need;
              if (n >= 4) ATT_BAR(8); else if (n == 3) ATT_BAR(6); else if (n == 2) ATT_BAR(4); else if (n == 1) ATT_BAR(2); else ATT_BAR(0); }
        }
        { auto rr = __builtin_amdgcn_permlane32_swap(__float_as_uint(l_reg), __float_as_uint(l_reg), false, false); l_reg = __uint_as_float(rr[0]) + __uint_as_float(rr[1]); }
        const float linv = 0.125f / l_reg;
        if (qg + 1 < NQG) { const int nt_lo = c0 + 4 - 8 > 0 ? c0 + 4 - 8 : 0;
            ATT_DMA(nt_lo, 0); ATT_DMA(nt_lo + 1, 1); ATT_DMA(nt_lo + 2, 2); ATT_DMA(nt_lo + 3, 3); ATT_QLOAD(qw0 + 256); }
        const size_t orow0 = rowb + qw0;
        u32x4 gv[8];
#pragma unroll
        for (int i = 0; i < 8; ++i) gv[i] = *(const u32x4*)(T.G + (orow0 + 4 * i + (lane >> 4)) * PITCH + h * 128 + (lane & 15) * 8);
        ATT_LAS unsigned char* stg = lds + (wid < 4 ? LDS_V + 4 * KB8 + wid * 8192 : LDS_K + 4 * KB8 + (wid - 4) * 8192);
#pragma unroll
        for (int d0 = 0; d0 < 4; ++d0)
#pragma unroll
            for (int rq = 0; rq < 4; ++rq) { u32x2 w; w.x = cvtpk(o[d0][4 * rq] * linv, o[d0][4 * rq + 1] * linv); w.y = cvtpk(o[d0][4 * rq + 2] * linv, o[d0][4 * rq + 3] * linv);
                *(ATT_LAS u32x2*)(stg + r32 * 256 + (((4 * d0 + rq) ^ (r32 & 15)) << 4) + 8 * hi) = w; }
        __builtin_amdgcn_fence(__ATOMIC_RELEASE, "wavefront"); asm volatile("s_waitcnt lgkmcnt(0)" ::: "memory");
#pragma unroll
        for (int i = 0; i < 8; ++i) { const int row = 4 * i + (lane >> 4), ch = lane & 15;
            const u32x4 ov = *(const ATT_LAS u32x4*)(stg + row * 256 + ((ch ^ (row & 15)) << 4));
            int r8[2] = {0, 0};
#pragma unroll
            for (int j = 0; j < 4; ++j) {
                const float o_lo = __uint_as_float(ov[j] << 16), o_hi = __uint_as_float(ov[j] & 0xffff0000u);
                const float g_lo = __uint_as_float(gv[i][j] << 16), g_hi = __uint_as_float(gv[i][j] & 0xffff0000u);
                const float s_lo = g_lo * __builtin_amdgcn_rcpf(1.0f + __builtin_amdgcn_exp2f(-1.4426950408889634f * g_lo));
                const float s_hi = g_hi * __builtin_amdgcn_rcpf(1.0f + __builtin_amdgcn_exp2f(-1.4426950408889634f * g_hi));
                const float e0 = o_lo * s_lo * 64.0f, e1 = o_hi * s_hi * 64.0f;
                if (j & 1) r8[j >> 1] = __builtin_amdgcn_cvt_pk_fp8_f32(e0, e1, r8[j >> 1], true); else r8[j >> 1] = __builtin_amdgcn_cvt_pk_fp8_f32(e0, e1, r8[j >> 1], false); }
            *(u32x2*)((unsigned char*)T.O + (orow0 + row) * PITCH + h * 128 + ch * 8) = (u32x2){(unsigned)r8[0], (unsigned)r8[1]}; }
        ATT_BAR(0);
    }
#undef ATT_QLOAD
#undef ATT_DMA
}
#undef ATT_PK
}

namespace lru {
typedef short bf16x8 __attribute__((ext_vector_type(8)));
typedef float f32x4l __attribute__((ext_vector_type(4)));
typedef unsigned u32x4 __attribute__((ext_vector_type(4)));
typedef unsigned u32x2 __attribute__((ext_vector_type(2)));
#define LRU_LAS __attribute__((address_space(3)))
constexpr int SEQ = 2048, PITCH = 2048, NT = 32;
constexpr int L_RAW = 0  , L_A = 34816, L_G = 51200  , L_SC = 83968  , RAWB = 17408;
constexpr float LOG2E = 1.4426950408889634f, LN2 = 0.6931471805599453f;
__device__ __forceinline__ unsigned cvtpk(float lo, float hi) { unsigned r; asm volatile("v_cvt_pk_bf16_f32 %0, %1, %2" : "=v"(r) : "v"(lo), "v"(hi)); return r; }
__device__ __forceinline__ float bf_lo(unsigned w) { return __uint_as_float(w << 16); }
__device__ __forceinline__ float bf_hi(unsigned w) { return __uint_as_float(w & 0xffff0000u); }
__device__ __forceinline__ float sigmoidf_fast(float x) { return __builtin_amdgcn_rcpf(1.0f + __builtin_amdgcn_exp2f(-LOG2E * x)); }
struct Params { const unsigned short* U; const unsigned short* G; unsigned short* Y;
    const float* conv_w; const float* conv_b; const float* wa; const float* ba; const float* wx; const float* bx; const float* lam; };

__device__ __forceinline__ void lru_bn(LRU_LAS unsigned char* lds, const Params& P, int b, int n, int wv) {
    int tid_ = wg_tid(wv); asm volatile("" : "+v"(tid_));
    const int tid = tid_, lane = tid & 63, nn = lane & 15, kq = lane >> 4; const int wid = __builtin_amdgcn_readfirstlane(tid >> 6);
    const size_t rowb = (size_t)b * SEQ;
    const unsigned short* Ub = P.U + rowb * PITCH + n * 128; const unsigned short* Gb = P.G + rowb * PITCH + n * 128; unsigned short* Yb = P.Y + rowb * PITCH + n * 128;
    bf16x8 Ba[4], Bx[4];
    { const float* wa0 = P.wa + (size_t)n * 128 * 128 + 16 * wid + nn; const float* wx0 = P.wx + (size_t)n * 128 * 128 + 16 * wid + nn;
#pragma unroll
      for (int ks = 0; ks < 4; ++ks) { u32x4 ta, tx;
#pragma unroll
          for (int j2 = 0; j2 < 4; ++j2) { const int i0 = 32 * ks + 8 * kq + 2 * j2;
              ta[j2] = cvtpk(-LOG2E * wa0[(size_t)i0 * 128], -LOG2E * wa0[(size_t)(i0 + 1) * 128]); tx[j2] = cvtpk(-LOG2E * wx0[(size_t)i0 * 128], -LOG2E * wx0[(size_t)(i0 + 1) * 128]); }
          Ba[ks] = __builtin_bit_cast(bf16x8, ta); Bx[ks] = __builtin_bit_cast(bf16x8, tx); } }
    const int chl = 16 * wid + nn, chg = n * 128 + chl;
    const float c_ba = -LOG2E * P.ba[chg], c_bx = -LOG2E * P.bx[chg];
    const float c_sp = -8.0f * log1pf(expf(-P.lam[chg])) * LOG2E;
    const int tt4 = tid >> 5, cg = tid & 31;
    f32x4l cw0, cw1, cw2, cw3, cbv;
    { const float* cwp = P.conv_w + n * 128 + 4 * cg; cw0 = *(const f32x4l*)(cwp); cw1 = *(const f32x4l*)(cwp + 2048); cw2 = *(const f32x4l*)(cwp + 4096); cw3 = *(const f32x4l*)(cwp + 6144);
      cbv = *(const f32x4l*)(P.conv_b + n * 128 + 4 * cg); }
    LRU_LAS unsigned char* abuf = lds + L_A; LRU_LAS float* sc = (LRU_LAS float*)(lds + L_SC + wid * 2048);
    const __amdgpu_buffer_rsrc_t rU = __builtin_amdgcn_make_buffer_rsrc((void*)Ub, 0, (2047 * PITCH + 128) * 2, 0x00020000), rGt = __builtin_amdgcn_make_buffer_rsrc((void*)Gb, 0, (2047 * PITCH + 128) * 2, 0x00020000);
#define LRU_VOFF() ((lane_id_mb() >> 4) * (PITCH * 2) + (lane_id_mb() & 15) * 16 + wid * (4 * PITCH * 2))
#define LRU_DMA(rs, buf, i, vo, so) __builtin_amdgcn_raw_ptr_buffer_load_lds(rs, (LRU_LAS void*)((buf) + wid * 1024 + (i) * 8192), 16, (int)(vo), (int)(so), 0, 2  )
#define LRU_DMA_TILE(t) do { const int vo_ = LRU_VOFF(); LRU_LAS unsigned char* rb_ = lds + L_RAW + ((t) & 1) * RAWB; LRU_LAS unsigned char* gb_ = lds + L_G + ((t) & 1) * 16384; \
        const int su_ = ((t) * 64 - 3) * (PITCH * 2), sg_ = (t) * 64 * (PITCH * 2); \
        LRU_DMA(rU, rb_, 0, vo_, su_); LRU_DMA(rU, rb_, 1, vo_, su_ + 32 * PITCH * 2); if (wid == 0) { if (lane_id_mb() < 48) LRU_DMA(rU, rb_, 2, vo_, su_ + 64 * PITCH * 2); } \
        LRU_DMA(rGt, gb_, 0, vo_, sg_); LRU_DMA(rGt, gb_, 1, vo_, sg_ + 32 * PITCH * 2); } while (0)
#define LRU_BAR(N) do { asm volatile("s_waitcnt vmcnt(" #N ") lgkmcnt(0)" ::: "memory"); __builtin_amdgcn_s_barrier(); asm volatile("" ::: "memory"); } while (0)
    float hc = 0.f;
    { if (tid < 48) *(LRU_LAS u32x4*)(lds + L_RAW + tid * 16) = (u32x4){0u, 0u, 0u, 0u};
      const int vo_ = LRU_VOFF(); LRU_LAS unsigned char* rb_ = lds + L_RAW; LRU_LAS unsigned char* gb_ = lds + L_G;
      if (tid >= 48) LRU_DMA(rU, rb_, 0, vo_ - 3 * PITCH * 2, 0);
      LRU_DMA(rU, rb_, 1, vo_, 29 * PITCH * 2); if (wid == 0) { if (lane_id_mb() < 48) LRU_DMA(rU, rb_, 2, vo_, 61 * PITCH * 2); }
      LRU_DMA(rGt, gb_, 0, vo_, 0); LRU_DMA(rGt, gb_, 1, vo_, 32 * PITCH * 2); }
#define LRU_STORE_Y(tt, gb) do { const u32x4 y0 = *(const LRU_LAS u32x4*)((gb) + tid * 16), y1 = *(const LRU_LAS u32x4*)((gb) + (tid + 512) * 16); \
        *(u32x4*)(Yb + (size_t)((tt) * 64 + (tid >> 4)) * PITCH + (tid & 15) * 8) = y0; *(u32x4*)(Yb + (size_t)((tt) * 64 + 32 + (tid >> 4)) * PITCH + (tid & 15) * 8) = y1; } while (0)
    LRU_BAR(0);
    for (int t = 0; t < NT; ++t) {
        LRU_LAS unsigned char* raw = lds + L_RAW + (t & 1) * RAWB;
        LRU_LAS unsigned char* gbuf = lds + L_G + (t & 1) * 16384; LRU_LAS unsigned char* gnext = lds + L_G + ((t + 1) & 1) * 16384;
        if (t > 0) { LRU_STORE_Y(t - 1, gnext); asm volatile("s_waitcnt lgkmcnt(0)" ::: "memory"); }
        if (t + 1 < NT) LRU_DMA_TILE(t + 1);
        { u32x2 rr[7];
#pragma unroll
          for (int i = 0; i < 7; ++i) rr[i] = *(const LRU_LAS u32x2*)(raw + (4 * tt4 + i) * 256 + cg * 8);
#pragma unroll
          for (int i = 0; i < 4; ++i) { const int tk = 4 * tt4 + i;
              float v0 = cbv[0], v1 = cbv[1], v2 = cbv[2], v3 = cbv[3];
#define LRU_TAP(K, CW) do { const u32x2 x = rr[i + K]; v0 += CW[0] * bf_lo(x.x); v1 += CW[1] * bf_hi(x.x); v2 += CW[2] * bf_lo(x.y); v3 += CW[3] * bf_hi(x.y); } while (0)
              LRU_TAP(0, cw0); LRU_TAP(1, cw1); LRU_TAP(2, cw2); LRU_TAP(3, cw3);
#undef LRU_TAP
              u32x2 w; w.x = cvtpk(v0, v1); w.y = cvtpk(v2, v3);
              *(LRU_LAS u32x2*)(abuf + tk * 256 + (((cg >> 1) ^ (tk & 15)) << 4) + 8 * (cg & 1)) = w; } }
        asm volatile("s_waitcnt lgkmcnt(0)" ::: "memory"); __builtin_amdgcn_s_barrier(); asm volatile("" ::: "memory");
        f32x4l ra[4], rx[4];
#pragma unroll
        for (int blk = 0; blk < 4; ++blk) { const int row = 16 * blk + nn; ra[blk] = (f32x4l){c_ba, c_ba, c_ba, c_ba}; rx[blk] = (f32x4l){c_bx, c_bx, c_bx, c_bx};
#pragma unroll
            for (int ks = 0; ks < 4; ++ks) { const bf16x8 af = *(const LRU_LAS bf16x8*)(abuf + row * 256 + (((4 * ks + kq) ^ (row & 15)) << 4));
                ra[blk] = __builtin_amdgcn_mfma_f32_16x16x32_bf16(af, Ba[ks], ra[blk], 0, 0, 0);
                rx[blk] = __builtin_amdgcn_mfma_f32_16x16x32_bf16(af, Bx[ks], rx[blk], 0, 0, 0); } }
        typedef float f32x2l __attribute__((ext_vector_type(2)));
        float av[4][4], bv[4][4]; f32x4l sA, sB;
#pragma unroll
        for (int blk = 0; blk < 4; ++blk) { float A4 = 1.f, B4 = 0.f;
#pragma unroll
            for (int rp = 0; rp < 4; rp += 2) { const int tok0 = 16 * blk + 4 * kq + rp, tok1 = tok0 + 1;
                const unsigned short ub0 = *(const LRU_LAS unsigned short*)(abuf + tok0 * 256 + (((chl >> 3) ^ (tok0 & 15)) << 4) + (chl & 7) * 2);
                const unsigned short ub1 = *(const LRU_LAS unsigned short*)(abuf + tok1 * 256 + (((chl >> 3) ^ (tok1 & 15)) << 4) + (chl & 7) * 2);
                const f32x2l up = (f32x2l){__uint_as_float((unsigned)ub0 << 16), __uint_as_float((unsigned)ub1 << 16)};
                const f32x2l one = (f32x2l){1.0f, 1.0f};
                const f32x2l da = one + (f32x2l){__builtin_amdgcn_exp2f(ra[blk][rp]), __builtin_amdgcn_exp2f(ra[blk][rp + 1])}, di = one + (f32x2l){__builtin_amdgcn_exp2f(rx[blk][rp]), __builtin_amdgcn_exp2f(rx[blk][rp + 1])};
                const f32x2l pd = da * di; const f32x2l inv = (f32x2l){__builtin_amdgcn_rcpf(pd.x), __builtin_amdgcn_rcpf(pd.y)};
                const f32x2l r = di * inv, ig = da * inv;
                const f32x2l l2a = r * c_sp; const f32x2l a = (f32x2l){__builtin_amdgcn_exp2f(l2a.x), __builtin_amdgcn_exp2f(l2a.y)};
                const f32x2l oma = one - a, em = oma * ((f32x2l){2.0f, 2.0f} - oma);
                const f32x2l bb = (f32x2l){__builtin_amdgcn_sqrtf(em.x), __builtin_amdgcn_sqrtf(em.y)} * ig * up;
                av[blk][rp] = a.x; bv[blk][rp] = bb.x; av[blk][rp + 1] = a.y; bv[blk][rp + 1] = bb.y;
                A4 *= a.x; B4 = B4 * a.x + bb.x; A4 *= a.y; B4 = B4 * a.y + bb.y; }
            sA[blk] = A4; sB[blk] = B4; }
        *(LRU_LAS f32x4l*)(sc + (nn * 4 + kq) * 4) = sA; *(LRU_LAS f32x4l*)(sc + 256 + (nn * 4 + kq) * 4) = sB;
        __builtin_amdgcn_fence(__ATOMIC_RELEASE, "wavefront"); asm volatile("s_waitcnt lgkmcnt(0)" ::: "memory");
        f32x4l gA[4], gB[4];
#pragma unroll
        for (int q = 0; q < 4; ++q) { gA[q] = *(const LRU_LAS f32x4l*)(sc + nn * 16 + q * 4); gB[q] = *(const LRU_LAS f32x4l*)(sc + 256 + nn * 16 + q * 4); }
        float hin[4]; float h = hc;
#pragma unroll
        for (int s = 0; s < 16; ++s) { const int blk = s >> 2, q = s & 3; if (q == kq) hin[blk] = h; h = gA[q][blk] * h + gB[q][blk]; }
        hc = h;
        asm volatile("" ::: "memory");
#pragma unroll
        for (int blk = 0; blk < 4; ++blk) { float hh = hin[blk];
#pragma unroll
            for (int rg = 0; rg < 4; ++rg) { const int tok = 16 * blk + 4 * kq + rg;
                hh = av[blk][rg] * hh + bv[blk][rg];
                LRU_LAS unsigned short* gp = (LRU_LAS unsigned short*)(gbuf + tok * 256 + chl * 2);
                const float sg = __uint_as_float((unsigned)(*gp) << 16);
                *gp = (unsigned short)(cvtpk(hh * sg, 0.f) & 0xffffu); } }
        LRU_BAR(0);
    }
    LRU_STORE_Y(NT - 1, lds + L_G + ((NT - 1) & 1) * 16384);
#undef LRU_STORE_Y
#undef LRU_DMA_TILE
#undef LRU_DMA
#undef LRU_VOFF
    __syncthreads();
}
}

#define GAS __attribute__((address_space(1)))
#define LAS __attribute__((address_space(3)))
typedef unsigned short bf16;
typedef unsigned v4u __attribute__((ext_vector_type(4)));
typedef unsigned v2u __attribute__((ext_vector_type(2)));
typedef float f32x4 __attribute__((ext_vector_type(4)));
typedef short bf16x8 __attribute__((ext_vector_type(8)));
typedef GAS unsigned gu32;
typedef GAS unsigned long long gu64;
#define RLX_AGENT __ATOMIC_RELAXED, __HIP_MEMORY_SCOPE_AGENT
#define LDS_WAIT() asm volatile("s_waitcnt lgkmcnt(0)" ::: "memory")
#define VM_WAIT() asm volatile("s_waitcnt vmcnt(0)" ::: "memory")
__device__ __forceinline__ unsigned long long rt() { return __builtin_amdgcn_s_memrealtime(); }
__device__ __forceinline__ unsigned f2bf(float f) { unsigned u = __builtin_bit_cast(unsigned, f); return (u + 0x7fffu + ((u >> 16) & 1u)) >> 16; }
__device__ __forceinline__ unsigned pk2(float lo, float hi) { return f2bf(lo) | (f2bf(hi) << 16); }

#define XB_TMO      128
#define XB_XCNT(j)  (256  + 64 * (j))
#define XB_XSUB(j)  (1280 + 64 * (j))
#define XB_XGEN(j)  (2304 + 64 * (j))
#define XB_TOP      3328
#define XB_TOPGEN   3392
#define XCD_BAR_WORDS 3456
#define XB_SPIN_CAP (1u << 18)

__device__ __forceinline__ unsigned xb_ld(unsigned* p)              { return __hip_atomic_load(p, __ATOMIC_RELAXED, __HIP_MEMORY_SCOPE_AGENT); }
__device__ __forceinline__ unsigned xb_add(unsigned* p, unsigned v) { return __hip_atomic_fetch_add(p, v, __ATOMIC_RELAXED, __HIP_MEMORY_SCOPE_AGENT); }
__device__ __forceinline__ unsigned xb_xcc_id() { return (unsigned)__builtin_amdgcn_s_getreg((3 << 11) | 20) & 0xFu; }
#define XB_SPIN(cond, bar) do { unsigned _sp = 0; while (cond) { __builtin_amdgcn_s_sleep(1); \
    if ((++_sp & 255u) == 0u) { if (xb_ld(&(bar)[XB_TMO])) break; if (_sp > XB_SPIN_CAP) { atomicAdd(&(bar)[XB_TMO], 1u); break; } } } } while (0)

struct XcdBarrier {
    unsigned* bar; unsigned x;
    volatile LAS unsigned* st;
    unsigned G;
};

__device__ __forceinline__ XcdBarrier xcd_barrier_post(unsigned* bar, volatile LAS unsigned* st, bool leader, unsigned G) {
    XcdBarrier b; b.bar = bar; b.x = xb_xcc_id(); b.st = st; b.G = G;
    if (leader) (void)xb_add(&bar[XB_XCNT(b.x)], 1u);
    return b;
}
__device__ __forceinline__ void xcd_barrier_complete(unsigned* bar, unsigned x, unsigned G, unsigned& nloc, unsigned& nx) {
    unsigned sum, cnt, mine, sp = 0u;
    for (;;) {
        sum = 0u; cnt = 0u; mine = 0u;
#pragma unroll
        for (unsigned j = 0; j < 16; ++j) { const unsigned c = xb_ld(&bar[XB_XCNT(j)]); sum += c; cnt += (c > 0u) ? 1u : 0u; mine = (j == x) ? c : mine; }
        if (sum == G) break;
        __builtin_amdgcn_s_sleep(1);
        if ((++sp & 255u) == 0u) { if (xb_ld(&bar[XB_TMO])) break; if (sp > XB_SPIN_CAP) { atomicAdd(&bar[XB_TMO], 1u); break; } }
    }
    nloc = mine > 0u ? mine : 1u; nx = cnt > 0u ? cnt : 1u;
}

__device__ __forceinline__ void xcd_barrier(const XcdBarrier& b, bool leader) {
    asm volatile("s_waitcnt vmcnt(0)" ::: "memory");
    __syncthreads();
    if (leader) {
        unsigned* bar = b.bar;
        __builtin_amdgcn_s_waitcnt(0);
        unsigned nloc = b.st[0], nx = b.st[1];
        if (nloc == 0u) { xcd_barrier_complete(bar, b.x, b.G, nloc, nx); b.st[0] = nloc; b.st[1] = nx; }
        const unsigned old = xb_add(&bar[XB_XSUB(b.x)], 1u);
        const unsigned gen = old / nloc;
        if (old + 1u == (gen + 1u) * nloc) {
            if (nx > 1u) {
            __builtin_amdgcn_fence(__ATOMIC_RELEASE, "agent");
            asm volatile("s_waitcnt vmcnt(0)" ::: "memory");
            const unsigned og = xb_add(&bar[XB_TOP], 1u);
            const unsigned tg = og / nx;
            if (og + 1u == (tg + 1u) * nx) xb_add(&bar[XB_TOPGEN], 1u);
            else XB_SPIN(xb_ld(&bar[XB_TOPGEN]) == tg, bar); }
            __builtin_amdgcn_fence(__ATOMIC_ACQUIRE, "agent");
            xb_add(&bar[XB_XGEN(b.x)], 1u);
            asm volatile("s_waitcnt vmcnt(0)" ::: "memory");
        } else {
            XB_SPIN(xb_ld(&bar[XB_XGEN(b.x)]) == gen, bar);
            __builtin_amdgcn_fence(__ATOMIC_ACQUIRE, "agent");
            asm volatile("s_waitcnt vmcnt(0)" ::: "memory");
        }
    }
    __syncthreads();
}

constexpr int NWAVES = 8;
constexpr int BATCH = 16, SEQ = 2048, DM = 2048, NH = 16, HD = 128;
constexpr int M = BATCH * SEQ;
constexpr int MH = M / 8;
constexpr int N1 = 4 * DM, N3 = 2 * DM;
constexpr float LN_EPS = 1e-5f;
constexpr float DN_ALPHA = 1.4142135623730951f;
constexpr float QSCALE = 0.08838834764831845f * 1.4426950408889634f;

constexpr size_t MiB = 1u << 20;
constexpr size_t WS_CTL = 0, CTL_ZERO_BYTES = 256 * 1024;
constexpr size_t WS_W1T = 2 * MiB, WS_W2T = 34 * MiB, WS_W3T = 42 * MiB, WS_W4T = 58 * MiB;
constexpr size_t WS_R0 = 80 * MiB, WS_R1 = 208 * MiB, WS_R2 = 336 * MiB, WS_R3 = 464 * MiB, WS_R4 = 592 * MiB, WS_HC = 720 * MiB, WS_END = 752 * MiB;
constexpr int CW_TMO = 0, CW_CODE = 1, CW_BAR = 4096;
constexpr int CW_BAR_STRIDE = 4096, NGRP = 8;
static_assert((CW_BAR + (1 + NGRP) * CW_BAR_STRIDE) * 4 <= (int)CTL_ZERO_BYTES && XCD_BAR_WORDS <= CW_BAR_STRIDE, "barrier words inside the memset region");

constexpr int RING_OFF = 0, RING_BYTES = 131072;
constexpr int LDSCTL_OFF = RING_BYTES, MISC_OFF = LDSCTL_OFF + 320, TL_OFF = LDSCTL_OFF + 1024;
constexpr int LDS_BYTES = 147456;
static_assert(TL_OFF + 640 * 4 <= LDS_BYTES, "LDS map");

struct Frame {
    LAS unsigned char* lds; volatile LAS unsigned* MISC; gu32* ctl;
    int tid, lane, wave, vcu, G;
};
__device__ __forceinline__ unsigned cvt_pk(float lo, float hi) { unsigned r; asm volatile("v_cvt_pk_bf16_f32 %0, %1, %2" : "=v"(r) : "v"(lo), "v"(hi)); return r; }
__device__ __forceinline__ float wave_sum(float v) {
#pragma unroll
    for (int o = 1; o < 64; o <<= 1) v += __shfl_xor(v, o);
    return v;
}
__device__ __forceinline__ unsigned h1_corr(float h, unsigned hb_bits) {
    const unsigned e8 = (hb_bits >> 23) & 0xffu; const float inv = __uint_as_float((265u - e8) << 23);
    int q = (int)__builtin_rintf((h - __uint_as_float(hb_bits)) * inv); q = e8 < 11u ? 0 : (q > 7 ? 7 : q);
    return (unsigned)q & 0xfu; }
__device__ __forceinline__ float h1_rebuild(unsigned hb_bits, unsigned cword, int sh) {
    const unsigned e8 = (hb_bits >> 23) & 0xffu; const float step = __uint_as_float(e8 < 12u ? 0u : (e8 - 11u) << 23);
    const int q = ((int)(cword << (28 - sh))) >> 28;
    return __uint_as_float(hb_bits) + (float)q * step; }
struct P0Mat { const float* W; bf16* WT; int N; int q8; int first; };
__device__ __forceinline__ void p0_item_load(const P0Mat& m, int item, int lane, f32x4 (&r)[8]) {
    const int nblk = m.N / 32, it = item - m.first, kb = it / nblk, nb = it % nblk;
    const float* p = m.W + (size_t)(64 * kb + (lane >> 3)) * m.N + 32 * nb + 4 * (lane & 7);
#pragma unroll
    for (int i = 0; i < 8; ++i) r[i] = *(const f32x4*)(p + (size_t)(8 * i) * m.N);
}
__device__ __forceinline__ void p0_item_store(const P0Mat& m, int item, int lane, const f32x4 (&r)[8], LAS float* scr) {
    const int K = DM, nblk = m.N / 32, it = item - m.first, kb = it / nblk, nb = it % nblk, k0 = 64 * kb, n0 = 32 * nb;
#pragma unroll
    for (int i = 0; i < 8; ++i) { LAS float* d = scr + (8 * i + (lane >> 3)) * 33 + 4 * (lane & 7); d[0] = r[i].x; d[1] = r[i].y; d[2] = r[i].z; d[3] = r[i].w; }
    LDS_WAIT(); asm volatile("" ::: "memory");
    const int c = lane & 7;
#pragma unroll
    for (int j = 0; j < 4; ++j) { const int n = (lane >> 3) + 8 * j; const LAS float* s = scr + (8 * c) * 33 + n;
        float v[8];
#pragma unroll
        for (int i = 0; i < 8; ++i) v[i] = s[i * 33];
        if (m.q8) { int w0 = 0, w1 = 0;
            w0 = __builtin_amdgcn_cvt_pk_fp8_f32(v[0] * 64.f, v[1] * 64.f, w0, false); w0 = __builtin_amdgcn_cvt_pk_fp8_f32(v[2] * 64.f, v[3] * 64.f, w0, true);
            w1 = __builtin_amdgcn_cvt_pk_fp8_f32(v[4] * 64.f, v[5] * 64.f, w1, false); w1 = __builtin_amdgcn_cvt_pk_fp8_f32(v[6] * 64.f, v[7] * 64.f, w1, true);
            *(GAS v2u*)((GAS unsigned char*)m.WT + (size_t)(n0 + n) * K + k0 + 8 * c) = (v2u){(unsigned)w0, (unsigned)w1};
        } else { v4u o; o.x = cvt_pk(v[0], v[1]); o.y = cvt_pk(v[2], v[3]); o.z = cvt_pk(v[4], v[5]); o.w = cvt_pk(v[6], v[7]);
            *(GAS v4u*)(m.WT + (size_t)(n0 + n) * K + k0 + 8 * c) = o; } }
    LDS_WAIT(); asm volatile("" ::: "memory");
}

struct Args { const float* in[15]; float* out; unsigned char* ws; int ph_lo, ph_hi; };
__global__ void __launch_bounds__(NWAVES * 64, 2) hybrid_fwd(Args args) {
    extern __shared__ __attribute__((aligned(16))) unsigned char lds[];
    Frame F;
    F.lds = (LAS unsigned char*)lds;
    F.MISC = (volatile LAS unsigned*)(F.lds + MISC_OFF);
    F.wave = __builtin_amdgcn_readfirstlane((int)threadIdx.x >> 6);
    const int bx = blockIdx.x, GT = gridDim.x, GH = GT / NGRP, grp = bx & 7, lb = bx >> 3;
    F.G = GH; F.vcu = lb;
    const int rowbase = grp * MH;
    unsigned char* ws = args.ws;
    F.ctl = (gu32*)(ws + WS_CTL);
    const float* x = args.in[0]; const float* attn_w_in = args.in[1]; const float* attn_w_out = args.in[2]; const float* rel_bias = args.in[3];
    const float* lru_w_in = args.in[4]; const float* conv_w = args.in[5]; const float* conv_b = args.in[6]; const float* lru_wa = args.in[7]; const float* lru_ba = args.in[8];
    const float* lru_wx = args.in[9]; const float* lru_bx = args.in[10]; const float* lru_lam = args.in[11]; const float* lru_w_out = args.in[12];
    const float* ln_gain = args.in[13]; const float* ln_bias = args.in[14];
    float* out = args.out;
    bf16* W1t = (bf16*)(ws + WS_W1T); bf16* W2t = (bf16*)(ws + WS_W2T); bf16* W3t = (bf16*)(ws + WS_W3T); bf16* W4t = (bf16*)(ws + WS_W4T);
    unsigned char* HC = ws + WS_HC;
    bf16* R0 = (bf16*)(ws + WS_R0); bf16* R1 = (bf16*)(ws + WS_R1); bf16* R2 = (bf16*)(ws + WS_R2); bf16* R3 = (bf16*)(ws + WS_R3); bf16* R4 = (bf16*)(ws + WS_R4);

    for (int u = (F.wave * 64 + lane_id_mb()); u < (LDS_BYTES - LDSCTL_OFF) / 4; u += NWAVES * 64) ((LAS unsigned*)(F.lds + LDSCTL_OFF))[u] = 0u;
    __syncthreads();
    XcdBarrier bar_all = xcd_barrier_post((unsigned*)(F.ctl + CW_BAR), F.MISC + 8, F.wave == 0 && lane_id_mb() == 0, (unsigned)GT);
    XcdBarrier bar = xcd_barrier_post((unsigned*)(F.ctl + CW_BAR + CW_BAR_STRIDE * (1 + grp)), F.MISC + 10, F.wave == 0 && lane_id_mb() == 0, (unsigned)GH);
    const int lo = args.ph_lo, hi = args.ph_hi;
#define IN(k) (lo <= (k) && (k) < hi)
#define GRID_BAR() xcd_barrier(bar, F.wave == 0 && lane_id_mb() == 0)
    const int gw = F.vcu * NWAVES + F.wave, NGW = GH * NWAVES;

    if (IN(0)) {
        constexpr int I1 = (DM / 64) * (N1 / 32), I2 = (DM / 64) * (DM / 32), I3 = (DM / 64) * (N3 / 32), I4 = I2, NITEMS = I1 + I2 + I3 + I4;
        const P0Mat m1{attn_w_in, W1t, N1, 1, 0}, m2{attn_w_out, W2t, DM, 1, I1}, m3{lru_w_in, W3t, N3, 0, I1 + I2}, m4{lru_w_out, W4t, DM, 0, I1 + I2 + I3};
#define P0_MAT(it) ((it) < I1 ? m1 : (it) < I1 + I2 ? m2 : (it) < I1 + I2 + I3 ? m3 : m4)
        { const int ln = lane_id_mb(); LAS unsigned char* wbuf = F.lds + RING_OFF + F.wave * 16384;
          const int it0 = ((bx % 8) * (GT / 8) + bx / 8) * NWAVES + F.wave, ist = GT * NWAVES;
#define W_DMA(it_, b_) do { const P0Mat mm_ = P0_MAT(it_); const int nblk_ = mm_.N / 32, itl_ = (it_) - mm_.first, kb_ = itl_ / nblk_, nb_ = itl_ % nblk_; \
              const __amdgpu_buffer_rsrc_t rw_ = __builtin_amdgcn_make_buffer_rsrc((void*)mm_.W, 0, (int)((unsigned)mm_.N * DM * 4u), 0x00020000); \
              const unsigned so_ = ((unsigned)(64 * kb_) * mm_.N + 32u * nb_) * 4u; const int l_ = lane_id_mb(); \
              _Pragma("unroll") for (int i = 0; i < 8; ++i) __builtin_amdgcn_raw_ptr_buffer_load_lds(rw_, (LAS void*)(wbuf + (b_) * 8192 + i * 1024), 16, \
                  (int)(((unsigned)(8 * i + (l_ >> 3)) * mm_.N) * 4u + ((unsigned)((l_ & 7) ^ i) << 4)), (int)so_, 0, 2  ); } while (0)
          if (it0 < NITEMS) W_DMA(it0, 0);
          if (it0 + ist < NITEMS) W_DMA(it0 + ist, 1);
          v4u ob[4]; int itp = -1, k = 0;
#pragma unroll
          for (int j = 0; j < 4; ++j) ob[j] = (v4u){0u, 0u, 0u, 0u};
#define W_STORE() do { const P0Mat mp_ = P0_MAT(itp); const int nblk_ = mp_.N / 32, itl_ = itp - mp_.first, k0_ = 64 * (itl_ / nblk_), n0_ = 32 * (itl_ % nblk_), c_ = ln & 7; \
              _Pragma("unroll") for (int j = 0; j < 4; ++j) { const int n_ = (ln >> 3) + 8 * j; \
                  if (mp_.q8) *(GAS v2u*)((GAS unsigned char*)mp_.WT + (size_t)(n0_ + n_) * DM + k0_ + 8 * c_) = (v2u){ob[j].x, ob[j].y}; \
                  else *(GAS v4u*)(mp_.WT + (size_t)(n0_ + n_) * DM + k0_ + 8 * c_) = ob[j]; } } while (0)
          for (int it = it0; it < NITEMS; it += ist, k ^= 1) {
              if (it + ist < NITEMS) asm volatile("s_waitcnt vmcnt(8)" ::: "memory"); else asm volatile("s_waitcnt vmcnt(0)" ::: "memory");
              float v[4][8];
              { const int c = ln & 7;
#pragma unroll
                for (int j = 0; j < 4; ++j) { const int n = (ln >> 3) + 8 * j; const LAS unsigned char* sp = wbuf + k * 8192 + (8 * c) * 128 + (((n >> 2) ^ c) << 4) + (n & 3) * 4;
#pragma unroll
                    for (int i = 0; i < 8; ++i) v[j][i] = *(const LAS float*)(sp + i * 128); } }
              asm volatile("s_waitcnt lgkmcnt(0)" ::: "memory");
              if (itp >= 0) W_STORE();
              if (it + 2 * ist < NITEMS) W_DMA(it + 2 * ist, k);
              const bool q8 = P0_MAT(it).q8 != 0;
#pragma unroll
              for (int j = 0; j < 4; ++j) {
                  if (q8) { int w0 = 0, w1 = 0;
                      w0 = __builtin_amdgcn_cvt_pk_fp8_f32(v[j][0] * 64.f, v[j][1] * 64.f, w0, false); w0 = __builtin_amdgcn_cvt_pk_fp8_f32(v[j][2] * 64.f, v[j][3] * 64.f, w0, true);
                      w1 = __builtin_amdgcn_cvt_pk_fp8_f32(v[j][4] * 64.f, v[j][5] * 64.f, w1, false); w1 = __builtin_amdgcn_cvt_pk_fp8_f32(v[j][6] * 64.f, v[j][7] * 64.f, w1, true);
                      ob[j] = (v4u){(unsigned)w0, (unsigned)w1, 0u, 0u};
                  } else ob[j] = (v4u){cvt_pk(v[j][0], v[j][1]), cvt_pk(v[j][2], v[j][3]), cvt_pk(v[j][4], v[j][5]), cvt_pk(v[j][6], v[j][7])}; }
              itp = it; }
          if (itp >= 0) W_STORE();
#undef W_STORE
#undef W_DMA
        }
#undef P0_MAT
        { LAS unsigned char* rbuf = F.lds + RING_OFF + F.wave * 16384; const int ln = lane_id_mb();
          const __amdgpu_buffer_rsrc_t rX = __builtin_amdgcn_make_buffer_rsrc((void*)x, 0, (int)((unsigned)M * DM * 4u), 0x00020000);
#define XROW_DMA(r_, b_) do { const unsigned sx_ = (unsigned)(r_) * (DM * 4u); const int vo_ = lane_id_mb() * 16; \
              _Pragma("unroll") for (int j = 0; j < 8; ++j) __builtin_amdgcn_raw_ptr_buffer_load_lds(rX, (LAS void*)(rbuf + (b_) * 8192 + j * 1024), 16, vo_, (int)(sx_ + j * 1024u), 0, 2  ); } while (0)
          const int r0 = rowbase + gw, rend = rowbase + MH;
          if (r0 < rend) XROW_DMA(r0, 0);
          if (r0 + NGW < rend) XROW_DMA(r0 + NGW, 1);
          v4u qp0 = (v4u){0u, 0u, 0u, 0u}, qp1 = qp0; int rp = -1, k = 0;
          for (int r = r0; r < rend; r += NGW, k ^= 1) {
              if (r + NGW < rend) asm volatile("s_waitcnt vmcnt(8)" ::: "memory"); else asm volatile("s_waitcnt vmcnt(0)" ::: "memory");
              f32x4 v[2][4];
#pragma unroll
              for (int jj = 0; jj < 2; ++jj)
#pragma unroll
                  for (int e = 0; e < 4; ++e) v[jj][e] = *(const LAS f32x4*)(rbuf + k * 8192 + (1024 * jj + 16 * ln + 4 * e) * 4);
              asm volatile("s_waitcnt lgkmcnt(0)" ::: "memory");
              if (rp >= 0) { GAS v4u* xq = (GAS v4u*)((GAS unsigned char*)R0 + (size_t)rp * DM); xq[ln] = qp0; xq[64 + ln] = qp1; }
              if (r + 2 * NGW < rend) XROW_DMA(r + 2 * NGW, k);
#pragma unroll
              for (int jj = 0; jj < 2; ++jj) { int w[4] = {0, 0, 0, 0};
#pragma unroll
                  for (int e = 0; e < 4; ++e) { w[e] = __builtin_amdgcn_cvt_pk_fp8_f32(v[jj][e].x, v[jj][e].y, w[e], false); w[e] = __builtin_amdgcn_cvt_pk_fp8_f32(v[jj][e].z, v[jj][e].w, w[e], true); }
                  if (jj == 0) qp0 = (v4u){(unsigned)w[0], (unsigned)w[1], (unsigned)w[2], (unsigned)w[3]}; else qp1 = (v4u){(unsigned)w[0], (unsigned)w[1], (unsigned)w[2], (unsigned)w[3]}; }
              rp = r; }
          if (rp >= 0) { GAS v4u* xq = (GAS v4u*)((GAS unsigned char*)R0 + (size_t)rp * DM); xq[ln] = qp0; xq[64 + ln] = qp1; }
#undef XROW_DMA
        }
        xcd_barrier(bar_all, F.wave == 0 && lane_id_mb() == 0);
    }
    if (IN(1)) {
        pg8::Gemm g{R0 + (size_t)rowbase * (DM / 2), W1t, MH, N1, DM / 2, 0x7f7f7f7f, 0x79797979}; pg8::StaticOrder S; S.init(MH, N1, GH, lb);
        pg8::EpiBf16<0> E{R1, DM, nullptr, DM, (size_t)(WS_R2 - WS_R1) / 2, QSCALE, -1, 3, rowbase};
        pg8::gemm_phase<pg8::EpiBf16<0>, pg8::StaticOrder, true, true, true>(F.lds + RING_OFF, g, S, E, F.wave);
        GRID_BAR();
    }
    if (IN(2)) {
        const att::Tensors T{R1, R2, R3, R4, R0, rel_bias};
        for (int bh = grp * (BATCH * NH / NGRP) + F.vcu; bh < (grp + 1) * (BATCH * NH / NGRP); bh += GH) att::attn_bh(F.lds + RING_OFF, (LAS float*)(F.lds + TL_OFF), T, bh / NH, bh % NH, F.wave);
        GRID_BAR();
    }
    if (IN(3)) {
        pg8::Gemm g{R0 + (size_t)rowbase * (DM / 2), W2t, MH, DM, DM / 2, 0x79797979, 0x79797979}; pg8::StaticOrder S; S.init(MH, DM, GH, lb);
        pg8::EpiBf16<0> E{R1, DM, nullptr, 0, 0, 1.0f, -1, 0, rowbase};
        pg8::gemm_phase<pg8::EpiBf16<0>, pg8::StaticOrder, true, true, true>(F.lds + RING_OFF, g, S, E, F.wave);
        GRID_BAR();
    }
    if (IN(4)) {
        const int ln = lane_id_mb();
        f32x4 gv[8], bv[8];
#pragma unroll
        for (int j = 0; j < 8; ++j) { gv[j] = *(const f32x4*)(ln_gain + 4 * ln + 256 * j); bv[j] = *(const f32x4*)(ln_bias + 4 * ln + 256 * j); }
        LAS unsigned char* rbuf = F.lds + RING_OFF + F.wave * 16384;
        const __amdgpu_buffer_rsrc_t rX = __builtin_amdgcn_make_buffer_rsrc((void*)x, 0, (int)((unsigned)M * DM * 4u), 0x00020000), rY = __builtin_amdgcn_make_buffer_rsrc((void*)R1, 0, (int)((unsigned)M * DM * 2u), 0x00020000);
#define ROW_DMA2(r_) do { const unsigned sx_ = (unsigned)(r_) * (DM * 4u), sy_ = (unsigned)(r_) * (DM * 2u); const int vo_ = lane_id_mb() * 16; \
            _Pragma("unroll") for (int j = 0; j < 8; ++j) __builtin_amdgcn_raw_ptr_buffer_load_lds(rX, (LAS void*)(rbuf + j * 1024), 16, vo_, (int)(sx_ + j * 1024u), 0, 2  ); \
            _Pragma("unroll") for (int j = 0; j < 4; ++j) __builtin_amdgcn_raw_ptr_buffer_load_lds(rY, (LAS void*)(rbuf + 8192 + j * 1024), 16, vo_, (int)(sy_ + j * 1024u), 0, 2); } while (0)
        const int rend = rowbase + MH;
        if (rowbase + gw < rend) ROW_DMA2(rowbase + gw);
        v2u hp[8]; v4u cp; int rp = -1;
#pragma unroll
        for (int j = 0; j < 8; ++j) hp[j] = (v2u){0u, 0u};
        cp = (v4u){0u, 0u, 0u, 0u};
#define ROW_STORE2() do { GAS v2u* o4 = (GAS v2u*)(R2 + (size_t)rp * DM) + ln; _Pragma("unroll") for (int j = 0; j < 8; ++j) o4[64 * j] = hp[j]; ((GAS v4u*)(HC + (size_t)rp * (DM / 2)))[ln] = cp; } while (0)
        for (int r = rowbase + gw; r < rend; r += NGW) {
            asm volatile("s_waitcnt vmcnt(0)" ::: "memory");
            f32x4 z[8]; float s = 0.f;
            { f32x4 xv[8]; v2u yv[8];
#pragma unroll
              for (int j = 0; j < 8; ++j) { xv[j] = *(const LAS f32x4*)(rbuf + (256 * j + 4 * ln) * 4); yv[j] = *(const LAS v2u*)(rbuf + 8192 + (256 * j + 4 * ln) * 2); }
              asm volatile("s_waitcnt lgkmcnt(0)" ::: "memory");
              if (r + NGW < rend) ROW_DMA2(r + NGW);
              if (rp >= 0) ROW_STORE2();
#pragma unroll
              for (int j = 0; j < 8; ++j) {
                  z[j] = xv[j] * DN_ALPHA + (f32x4){__uint_as_float(yv[j].x << 16), __uint_as_float(yv[j].x & 0xffff0000u), __uint_as_float(yv[j].y << 16), __uint_as_float(yv[j].y & 0xffff0000u)};
                  s += (z[j].x + z[j].y) + (z[j].z + z[j].w); } }
            const float mean = wave_sum(s) * (1.0f / DM); float q = 0.f;
#pragma unroll
            for (int j = 0; j < 8; ++j) { z[j] = z[j] - mean; q += (z[j].x * z[j].x + z[j].y * z[j].y) + (z[j].z * z[j].z + z[j].w * z[j].w); }
            const float rstd = 1.0f / sqrtf(wave_sum(q) * (1.0f / DM) + LN_EPS);
            unsigned cw[4] = {0u, 0u, 0u, 0u};
#pragma unroll
            for (int j = 0; j < 8; ++j) { const f32x4 h = (z[j] * rstd) * gv[j] + bv[j]; const v2u p = (v2u){cvt_pk(h.x, h.y), cvt_pk(h.z, h.w)}; hp[j] = p;
                const unsigned hb[4] = {p.x << 16, p.x & 0xffff0000u, p.y << 16, p.y & 0xffff0000u};
#pragma unroll
                for (int e = 0; e < 4; ++e) { cw[j >> 1] |= h1_corr(h[e], hb[e]) << (16 * (j & 1) + 4 * e); } }
            cp = (v4u){cw[0], cw[1], cw[2], cw[3]}; rp = r;
        }
        if (rp >= 0) ROW_STORE2();
#undef ROW_STORE2
#undef ROW_DMA2
        GRID_BAR();
    }
    if (IN(5)) {
        pg8::Gemm g{R2 + (size_t)rowbase * DM, W3t, MH, N3, DM, 0, 0}; pg8::StaticOrder S; S.init(MH, N3, GH, lb);
        pg8::EpiBf16<0> E{R0, DM, nullptr, DM, (size_t)(WS_R4 - WS_R0) / 2, 1.0f, 1, 0, rowbase};
        pg8::gemm_phase<pg8::EpiBf16<0>, pg8::StaticOrder, true, true>(F.lds + RING_OFF, g, S, E, F.wave);
        GRID_BAR();
    }
    if (IN(6)) {
        const lru::Params P{R0, R4, R3, conv_w, conv_b, lru_wa, lru_ba, lru_wx, lru_bx, lru_lam};
        for (int bn = grp * (BATCH * 16 / NGRP) + F.vcu; bn < (grp + 1) * (BATCH * 16 / NGRP); bn += GH) lru::lru_bn(F.lds + RING_OFF, P, bn / 16, bn % 16, F.wave);
        GRID_BAR();
    }
    if (IN(7)) {
        pg8::Gemm g{R3 + (size_t)rowbase * DM, W4t, MH, DM, DM, 0, 0}; pg8::StaticOrder S; S.init(MH, DM, GH, lb);
        pg8::EpiBf16<0> E{R1, DM, nullptr, 0, 0, 1.0f, -1, 0, rowbase};
        pg8::gemm_phase<pg8::EpiBf16<0>, pg8::StaticOrder, true, true>(F.lds + RING_OFF, g, S, E, F.wave);
        GRID_BAR();
    }
    if (IN(8)) {
        unsigned bad = __hip_atomic_load(F.ctl + CW_BAR + XB_TMO, RLX_AGENT);
#pragma unroll
        for (int gi = 1; gi <= NGRP; ++gi) bad |= __hip_atomic_load(F.ctl + CW_BAR + gi * CW_BAR_STRIDE + XB_TMO, RLX_AGENT);
        const int ln = lane_id_mb();
        f32x4 g1v[8], b1v[8];
#pragma unroll
        for (int j = 0; j < 8; ++j) { g1v[j] = *(const f32x4*)(ln_gain + DM + 4 * ln + 256 * j); b1v[j] = *(const f32x4*)(ln_bias + DM + 4 * ln + 256 * j); }
        LAS unsigned char* rbuf = F.lds + RING_OFF + F.wave * 16384;
        const __amdgpu_buffer_rsrc_t rH = __builtin_amdgcn_make_buffer_rsrc((void*)R2, 0, (int)((unsigned)M * DM * 2u), 0x00020000), rW = __builtin_amdgcn_make_buffer_rsrc((void*)R1, 0, (int)((unsigned)M * DM * 2u), 0x00020000),
                                     rC = __builtin_amdgcn_make_buffer_rsrc((void*)HC, 0, (int)((unsigned)M * (DM / 2)), 0x00020000);
#define ROW_DMA3(r_) do { const unsigned sh_ = (unsigned)(r_) * (DM * 2u), sc_ = (unsigned)(r_) * (DM / 2); const int vo_ = lane_id_mb() * 16; \
            _Pragma("unroll") for (int j = 0; j < 4; ++j) __builtin_amdgcn_raw_ptr_buffer_load_lds(rH, (LAS void*)(rbuf + j * 1024), 16, vo_, (int)(sh_ + j * 1024u), 0, 2); \
            _Pragma("unroll") for (int j = 0; j < 4; ++j) __builtin_amdgcn_raw_ptr_buffer_load_lds(rW, (LAS void*)(rbuf + 4096 + j * 1024), 16, vo_, (int)(sh_ + j * 1024u), 0, 2); \
            __builtin_amdgcn_raw_ptr_buffer_load_lds(rC, (LAS void*)(rbuf + 8192), 16, vo_, (int)sc_, 0, 2); } while (0)
        const __amdgpu_buffer_rsrc_t rOut = __builtin_amdgcn_make_buffer_rsrc((void*)out, 0, (int)((unsigned)M * DM * 4u), 0x00020000);
        const int rend = rowbase + MH;
        if (rowbase + gw < rend) ROW_DMA3(rowbase + gw);
        f32x4 op[8]; int rp = -1;
#pragma unroll
        for (int j = 0; j < 8; ++j) op[j] = (f32x4){0.f, 0.f, 0.f, 0.f};
#define ROW_STORE3() do { _Pragma("unroll") for (int j = 0; j < 8; ++j) __builtin_amdgcn_raw_buffer_store_b128(__builtin_bit_cast(v4u, op[j]), rOut, ln * 16 + j * 1024, (int)((unsigned)rp * (DM * 4u)), 16  ); } while (0)
        for (int r = rowbase + gw; r < rend; r += NGW) {
            asm volatile("s_waitcnt vmcnt(0)" ::: "memory");
            f32x4 z[8]; float s = 0.f;
            { v2u hv[8], wv[8]; const v4u cn = *(const LAS v4u*)(rbuf + 8192 + ln * 16);
#pragma unroll
              for (int j = 0; j < 8; ++j) { hv[j] = *(const LAS v2u*)(rbuf + (256 * j + 4 * ln) * 2); wv[j] = *(const LAS v2u*)(rbuf + 4096 + (256 * j + 4 * ln) * 2); }
              asm volatile("s_waitcnt lgkmcnt(0)" ::: "memory");
              if (r + NGW < rend) ROW_DMA3(r + NGW);
              if (rp >= 0) ROW_STORE3();
#pragma unroll
              for (int j = 0; j < 8; ++j) { const unsigned cwd = cn[j >> 1]; const int sh = 16 * (j & 1);
                  const f32x4 h = (f32x4){h1_rebuild(hv[j].x << 16, cwd, sh), h1_rebuild(hv[j].x & 0xffff0000u, cwd, sh + 4), h1_rebuild(hv[j].y << 16, cwd, sh + 8), h1_rebuild(hv[j].y & 0xffff0000u, cwd, sh + 12)};
                  z[j] = h * DN_ALPHA + (f32x4){__uint_as_float(wv[j].x << 16), __uint_as_float(wv[j].x & 0xffff0000u), __uint_as_float(wv[j].y << 16), __uint_as_float(wv[j].y & 0xffff0000u)};
                  s += (z[j].x + z[j].y) + (z[j].z + z[j].w); } }
            const float mean = wave_sum(s) * (1.0f / DM); float q = 0.f;
#pragma unroll
            for (int j = 0; j < 8; ++j) { z[j] = z[j] - mean; q += (z[j].x * z[j].x + z[j].y * z[j].y) + (z[j].z * z[j].z + z[j].w * z[j].w); }
            float rstd = 1.0f / sqrtf(wave_sum(q) * (1.0f / DM) + LN_EPS);
            if (bad) rstd = __builtin_nanf("");
#pragma unroll
            for (int j = 0; j < 8; ++j) op[j] = (z[j] * rstd) * g1v[j] + b1v[j];
            rp = r;
        }
        if (rp >= 0) ROW_STORE3();
#undef ROW_STORE3
#undef ROW_DMA3
    }
#undef IN
#undef GRID_BAR
}

extern "C" void kernel_launch(void* const* d_in, const int* in_sizes, int n_in, void* d_out, int out_size, void* d_ws, size_t ws_size, hipStream_t stream) {
    static int grid = 0;
    if (grid == 0) {
        if (n_in != 15 || in_sizes[0] != M * DM || out_size != M * DM || ws_size < WS_END) {
            fprintf(stderr, "kernel_launch: built for 15 inputs, x/out of %d floats, >= %zu bytes of workspace; got n_in %d in0 %d out %d ws %zu\n", M * DM, (size_t)WS_END, n_in, n_in > 0 ? in_sizes[0] : -1, out_size, ws_size);
            grid = -1; return; }
        int dev = 0, cus = 0;
        if (hipGetDevice(&dev) != hipSuccess || hipDeviceGetAttribute(&cus, hipDeviceAttributeMultiprocessorCount, dev) != hipSuccess) { grid = -1; return; }
        if (hipFuncSetAttribute((const void*)hybrid_fwd, hipFuncAttributeMaxDynamicSharedMemorySize, LDS_BYTES) != hipSuccess) { fprintf(stderr, "kernel_launch: hipFuncSetAttribute failed\n"); grid = -1; return; }
        (void)hipGetLastError();
        grid = cus - cus % 8;
        if (grid != 256) fprintf(stderr, "kernel_launch: note: %d CUs (tuned for 256)\n", grid);
    }
    if (grid < 0) return;
    if (hipMemsetAsync((char*)d_ws + WS_CTL, 0, CTL_ZERO_BYTES, stream) != hipSuccess) { fprintf(stderr, "kernel_launch: hipMemsetAsync failed\n"); return; }
    Args a{};
    for (int i = 0; i < 15; ++i) a.in[i] = (const float*)d_in[i];
    a.out = (float*)d_out; a.ws = (unsigned char*)d_ws; a.ph_lo = 0; a.ph_hi = 9;
    hipLaunchKernelGGL(hybrid_fwd, dim3(grid), dim3(NWAVES * 64), LDS_BYTES, stream, a);
    const hipError_t le = hipPeekAtLastError();
    if (le != hipSuccess) fprintf(stderr, "kernel_launch: launch failed: %s\n", hipGetErrorName(le));
}
```
